# Optimizing an MI355X kernel written in HIP

```python
import jax, jax.numpy as jnp
from jax import lax
import numpy as np

D_MODEL = 2048
BATCH = 2
SEQ = 4096
DEPTH = 1

N_META = 16
ATTN_HEADS = 8
HEAD_DIM = 128
ATTN_WIDTH = ATTN_HEADS * HEAD_DIM
CONV_GROUPS = 8
CONV_WIDTH = 1024
CONV_K = 3
N_BRANCH = 2
D_FF = 4 * D_MODEL
BLOCK_Q = 128
EPS = 1e-6
FGATE_BIAS = 3.0
COL_SIZES = (ATTN_WIDTH, ATTN_WIDTH, ATTN_WIDTH, ATTN_HEADS,
             CONV_WIDTH, CONV_WIDTH, CONV_WIDTH, N_BRANCH * D_MODEL)
IN_COLS = 3 * ATTN_WIDTH + ATTN_HEADS + 3 * CONV_WIDTH + N_BRANCH * D_MODEL

kernel_name = "fox_shortconv_gated_hybrid_block"


def rms_norm(x, g):
    xf = x.astype(jnp.float32)
    y = xf * lax.rsqrt(jnp.mean(xf * xf, axis=-1, keepdims=True) + EPS)
    return (y * g.astype(jnp.float32)).astype(x.dtype)


def split_offsets():
    offs, acc = [], 0
    for s in COL_SIZES[:-1]:
        acc += s
        offs.append(acc)
    return offs


def fox_block(qb, cq, qpos, k, v, ck, kpos):
    scale = HEAD_DIM ** -0.5
    s = jnp.einsum('bqhd,bkhd->bhqk', qb, k).astype(jnp.float32) * scale
    s = s + cq.transpose(0, 2, 1)[:, :, :, None] - ck.transpose(0, 2, 1)[:, :, None, :]
    mask = kpos[None, :] <= qpos[:, None]
    s = jnp.where(mask[None, None], s, -jnp.inf)
    p = jax.nn.softmax(s, axis=-1)
    return jnp.einsum('bhqk,bkhd->bqhd', p.astype(v.dtype), v)


def forgetting_attention(q, k, v, log_f):
    B, L, H, Dh = q.shape
    cum = jnp.cumsum(log_f, axis=1)
    pos = jnp.arange(L, dtype=jnp.int32)
    meta_out = fox_block(q[:, :N_META], cum[:, :N_META], pos[:N_META],
                         k[:, :N_META], v[:, :N_META], cum[:, :N_META], pos[:N_META])
    nb = (L - N_META) // BLOCK_Q
    qr = q[:, N_META:].reshape(B, nb, BLOCK_Q, H, Dh).transpose(1, 0, 2, 3, 4)
    cr = cum[:, N_META:].reshape(B, nb, BLOCK_Q, H).transpose(1, 0, 2, 3)
    pr = pos[N_META:].reshape(nb, BLOCK_Q)
    real = lax.map(lambda a: fox_block(a[0], a[1], a[2], k, v, cum, pos), (qr, cr, pr))
    real = real.transpose(1, 0, 2, 3, 4).reshape(B, L - N_META, H, Dh)
    return jnp.concatenate([meta_out, real], axis=1)


def short_conv(u, w):
    L = u.shape[1]
    up = jnp.pad(u, ((0, 0), (CONV_K - 1, 0), (0, 0)))
    y = w[0] * up[:, 0:L]
    for j in range(1, CONV_K):
        y = y + w[j] * up[:, j:j + L]
    return y


def setup_inputs(seed: int = 0) -> dict:
    key = jax.random.key(seed)
    ks = jax.random.split(key, 16)
    f32 = jnp.float32
    nrm = lambda k, shape, scale: jax.random.normal(k, shape, f32) * scale
    x = jax.random.normal(ks[0], (BATCH, SEQ, D_MODEL), f32)
    meta_tokens = nrm(ks[1], (N_META, D_MODEL), 1.0)
    norm_mix = 1.0 + nrm(ks[2], (DEPTH, D_MODEL), 0.02)
    w_in = nrm(ks[3], (DEPTH, D_MODEL, IN_COLS), D_MODEL ** -0.5)
    b_fgate = FGATE_BIAS + nrm(ks[4], (DEPTH, ATTN_HEADS), 0.1)
    b_gate = nrm(ks[5], (DEPTH, N_BRANCH * D_MODEL), 0.01)
    q_norm = 1.0 + nrm(ks[6], (DEPTH, HEAD_DIM), 0.02)
    k_norm = 1.0 + nrm(ks[7], (DEPTH, HEAD_DIM), 0.02)
    conv_w = nrm(ks[8], (DEPTH, CONV_K, CONV_WIDTH), CONV_K ** -0.5)
    w_attn_out = nrm(ks[9], (DEPTH, ATTN_WIDTH, D_MODEL), ATTN_WIDTH ** -0.5)
    w_conv_out = nrm(ks[10], (DEPTH, CONV_WIDTH, D_MODEL), CONV_WIDTH ** -0.5)
    w_o = nrm(ks[11], (DEPTH, D_MODEL, D_MODEL), D_MODEL ** -0.5)
    norm_mlp = 1.0 + nrm(ks[12], (DEPTH, D_MODEL), 0.02)
    w_up = nrm(ks[13], (DEPTH, D_MODEL, D_FF), D_MODEL ** -0.5)
    w_down = nrm(ks[14], (DEPTH, D_FF, D_MODEL), D_FF ** -0.5)
    return {"x": x, "meta_tokens": meta_tokens, "norm_mix": norm_mix, "w_in": w_in,
            "b_fgate": b_fgate, "b_gate": b_gate, "q_norm": q_norm, "k_norm": k_norm,
            "conv_w": conv_w, "w_attn_out": w_attn_out, "w_conv_out": w_conv_out,
            "w_o": w_o, "norm_mlp": norm_mlp, "w_up": w_up, "w_down": w_down}


def reference(x, meta_tokens, norm_mix, w_in, b_fgate, b_gate, q_norm, k_norm,
              conv_w, w_attn_out, w_conv_out, w_o, norm_mlp, w_up, w_down):
    B = x.shape[0]
    meta = jnp.broadcast_to(meta_tokens[None].astype(x.dtype), (B, N_META, D_MODEL))
    h = jnp.concatenate([meta, x], axis=1)
    L = h.shape[1]
    offs = split_offsets()
    for layer in range(DEPTH):
        xn = rms_norm(h, norm_mix[layer])
        proj = jnp.einsum('bld,dc->blc', xn, w_in[layer])
        q, k, v, fg, cb, cc, cx, gl = jnp.split(proj, offs, axis=-1)
        q = rms_norm(q.reshape(B, L, ATTN_HEADS, HEAD_DIM), q_norm[layer])
        k = rms_norm(k.reshape(B, L, ATTN_HEADS, HEAD_DIM), k_norm[layer])
        v = v.reshape(B, L, ATTN_HEADS, HEAD_DIM)
        log_f = jax.nn.log_sigmoid(fg.astype(jnp.float32) + b_fgate[layer].astype(jnp.float32))
        a = forgetting_attention(q, k, v, log_f).reshape(B, L, ATTN_WIDTH)
        a = jnp.einsum('blc,cd->bld', a, w_attn_out[layer])
        c = cb * short_conv(cc * cx, conv_w[layer])
        c = jnp.einsum('blc,cd->bld', c, w_conv_out[layer])
        g = jax.nn.sigmoid(gl.astype(jnp.float32) + b_gate[layer].astype(jnp.float32))
        g = g.astype(h.dtype).reshape(B, L, N_BRANCH, D_MODEL)
        merged = g[:, :, 0] * a + g[:, :, 1] * c
        h = h + jnp.einsum('bld,de->ble', merged, w_o[layer])
        hn = rms_norm(h, norm_mlp[layer])
        u = jnp.square(jax.nn.relu(jnp.einsum('bld,df->blf', hn, w_up[layer])))
        h = h + jnp.einsum('blf,fd->bld', u, w_down[layer])
    return h[:, N_META:]
```

```cpp
#include <hip/hip_runtime.h>
#include <hip/hip_cooperative_groups.h>
#include <hip/hip_bf16.h>
#include <cstdio>
#include <cstdint>
namespace cg = cooperative_groups;

#ifndef MK_N_LAUNCHES
#define MK_N_LAUNCHES 1
#endif

constexpr int DM = 2048, NB = 2, SEQ = 4096, NMETA = 16, LTOT = NMETA + SEQ;
constexpr int NH = 8, HD = 128, AW = 1024, CW = 1024, DFF = 8192;
constexpr int MROWS = NB * SEQ;
constexpr int INC = 10248;
constexpr int NIN = 10240;
constexpr int LP = 4160;
constexpr int UBR = SEQ + 2;
constexpr float EPS = 1e-6f;
constexpr float LOG2E = 1.4426950408889634f;
constexpr float QSCALE = 0.08838834764831845f * LOG2E;
constexpr float WG_SCALE = 64.f;

__device__ __forceinline__ int lane_now() { int l; asm volatile("v_mbcnt_lo_u32_b32 %0, -1, 0\n\tv_mbcnt_hi_u32_b32 %0, -1, %0" : "=v"(l)); return l; }
namespace pg8 {
#define PG8_LAS __attribute__((address_space(3)))
typedef unsigned short bf16_t;
typedef short bf16x8 __attribute__((ext_vector_type(8)));
typedef float f32x4 __attribute__((ext_vector_type(4)));
typedef unsigned u32x4 __attribute__((ext_vector_type(4)));
typedef int i32x4 __attribute__((ext_vector_type(4)));
typedef int i32x8 __attribute__((ext_vector_type(8)));
constexpr int BM = 256, BK = 64, HALF = 128, HTB = HALF * BK * 2, STAGE_BYTES = 8 * HTB, NXCD = 8, WGM = 4;

__host__ __device__ __forceinline__ int lds_byte(int r, int c) { const int st = (r >> 4) * 2 + (c >> 5), rr = r & 15, cc = c & 31, ob = rr * 64 + cc * 2; return st * 1024 + (ob ^ (((ob >> 9) & 1) << 5)); }
__host__ __device__ __forceinline__ void stage_rc(int b, int& R, int& C) { const int st = b / 1024, sb = b % 1024, swz = sb ^ (((sb >> 9) & 1) << 5); R = (st >> 1) * 16 + swz / 64; C = (st & 1) * 32 + (swz % 64) / 2; }
__host__ __device__ __forceinline__ int perm32(int rho) { const int n = rho >> 4, i = rho & 15; return 8 * (i >> 2) + 4 * n + (i & 3); }

struct Unit { int pm, pn, ko; };
struct Gemm { const bf16_t* A; const bf16_t* Bt; int ld, K; };

struct StaticOrder {
    int nM, nN, nwg, G, c;
    __host__ __device__ void init(int M, int N, int G_, int c_) { nM = M / BM; nN = N / BM; nwg = nM * nN; G = G_; c = c_; }
    __host__ __device__ bool next(int i, Unit& u) const {
        const long L = (long)i * G + c; if (L >= nwg) return false;
        int wgid = (int)L; { const int q = nwg / NXCD, r = nwg % NXCD, xcd = wgid % NXCD, off = wgid / NXCD; wgid = (xcd < r ? xcd * (q + 1) : r * (q + 1) + (xcd - r) * q) + off; }
        const int nig = WGM * nN, gid = wgid / nig, fm = gid * WGM, gsz = (nM - fm) < WGM ? (nM - fm) : WGM;
        u.pm = fm + ((wgid % nig) % gsz); u.pn = (wgid % nig) / gsz; u.ko = 0; return true;
    }
};
struct TwoPassOrder {
    StaticOrder S; int khalf;
    __device__ bool next(int i, Unit& u) const { if (!S.next(i >> 1, u)) return false; u.ko = (i & 1) * khalf; return true; }
};

typedef float f32x2_t __attribute__((ext_vector_type(2))); typedef __bf16 bf16x2_t __attribute__((ext_vector_type(2)));
__device__ __forceinline__ unsigned cvt_pk_bf16(float lo, float hi) { f32x2_t v = {lo, hi}; bf16x2_t b = __builtin_convertvector(v, bf16x2_t); return __builtin_bit_cast(unsigned, b); }
__device__ __forceinline__ u32x4 pack8(f32x4 a, f32x4 b) { u32x4 w; w.x = cvt_pk_bf16(a[0], a[1]); w.y = cvt_pk_bf16(a[2], a[3]); w.z = cvt_pk_bf16(b[0], b[1]); w.w = cvt_pk_bf16(b[2], b[3]); return w; }
__device__ __forceinline__ void unpack8(u32x4 w, f32x4& a, f32x4& b) {
    a[0] = __uint_as_float(w.x << 16); a[1] = __uint_as_float(w.x & 0xffff0000u); a[2] = __uint_as_float(w.y << 16); a[3] = __uint_as_float(w.y & 0xffff0000u);
    b[0] = __uint_as_float(w.z << 16); b[1] = __uint_as_float(w.z & 0xffff0000u); b[2] = __uint_as_float(w.w << 16); b[3] = __uint_as_float(w.w & 0xffff0000u);
}
__device__ __forceinline__ float dot4(f32x4 a) { return (a[0] * a[0] + a[1] * a[1]) + (a[2] * a[2] + a[3] * a[3]); }


struct EpiInProj {
    static constexpr bool PERM = true, AFTER_DRAIN = false, MIDK = false;
    bf16_t *Q, *Kb, *Vb, *UB, *CB; const float *qn, *kn; PG8_LAS float* scr;
    __device__ __forceinline__ void operator()(const f32x4 (&acc)[2][2][4][2], const Unit& u, int wr, int wc, int fr, int fq) const {
        const int pn = u.pn, pm = u.pm, b = pm >> 4, t0 = (pm & 15) * 256; int rl0 = wr * 64 + fr, c8 = wc * 32 + 8 * fq;
        asm volatile("" : "+v"(rl0), "+v"(c8));
        if (pn < 8) {
            const bool isq = pn < 4; const int hp = (isq ? pn : pn - 4) * 2; const float* gn = isq ? qn : kn;
            f32x4 g0 = *(const f32x4*)(gn + c8), g1 = *(const f32x4*)(gn + c8 + 4);
            if (isq) { g0 = g0 * QSCALE; g1 = g1 * QSCALE; }
#pragma unroll
            for (int ai = 0; ai < 2; ++ai)
#pragma unroll
                for (int m = 0; m < 4; ++m)
#pragma unroll
                    for (int bj = 0; bj < 2; ++bj) {
                        float s = dot4(acc[ai][bj][m][0]) + dot4(acc[ai][bj][m][1]);
                        s += __shfl_xor(s, 16); s += __shfl_xor(s, 32);
                        if (fq == 0) scr[((ai * 128 + rl0 + 16 * m) * 2 + bj) * 4 + wc] = s;
                    }
            asm volatile("s_waitcnt lgkmcnt(0)" ::: "memory"); __builtin_amdgcn_s_barrier(); asm volatile("" ::: "memory");
#pragma unroll
            for (int ai = 0; ai < 2; ++ai)
#pragma unroll
                for (int m = 0; m < 4; ++m) {
                    const int rl = ai * 128 + rl0 + 16 * m, t = t0 + rl;
#pragma unroll
                    for (int bj = 0; bj < 2; ++bj) {
                        const f32x4 p = *(const PG8_LAS f32x4*)(scr + (rl * 2 + bj) * 4);
                        const float rstd = rsqrtf(((p[0] + p[1]) + (p[2] + p[3])) * (1.0f / 128.0f) + EPS);
                        const f32x4 v0 = acc[ai][bj][m][0] * rstd * g0, v1 = acc[ai][bj][m][1] * rstd * g1;
                        const int bh = b * NH + hp + bj;
                        bf16_t* dst = isq ? Q + ((size_t)bh * SEQ + t) * HD + c8 : Kb + ((size_t)bh * LP + NMETA + t) * HD + c8;
                        *(u32x4*)dst = pack8(v0, v1);
                    }
                }
        } else if (pn < 12) {
#pragma unroll
            for (int ai = 0; ai < 2; ++ai)
#pragma unroll
                for (int m = 0; m < 4; ++m) { const int t = t0 + ai * 128 + rl0 + 16 * m;
#pragma unroll
                    for (int bj = 0; bj < 2; ++bj) { const int bh = b * NH + (pn - 8) * 2 + bj;
                        *(u32x4*)(Vb + ((size_t)bh * LP + NMETA + t) * HD + c8) = pack8(acc[ai][bj][m][0], acc[ai][bj][m][1]); } }
        } else if (pn < 20) {
            const int ch = (pn - 12) * 128 + c8;
#pragma unroll
            for (int ai = 0; ai < 2; ++ai)
#pragma unroll
                for (int m = 0; m < 4; ++m) { const int t = t0 + ai * 128 + rl0 + 16 * m;
                    *(u32x4*)(UB + ((size_t)b * UBR + 2 + t) * CW + ch) = pack8(acc[ai][0][m][0] * acc[ai][1][m][0], acc[ai][0][m][1] * acc[ai][1][m][1]); }
        } else {
#pragma unroll
            for (int ai = 0; ai < 2; ++ai)
#pragma unroll
                for (int m = 0; m < 4; ++m) { const size_t R = (size_t)pm * 256 + ai * 128 + rl0 + 16 * m;
#pragma unroll
                    for (int bj = 0; bj < 2; ++bj) *(u32x4*)(CB + R * CW + (pn - 20) * 256 + bj * 128 + c8) = pack8(acc[ai][bj][m][0], acc[ai][bj][m][1]); }
        }
    }
};
struct EpiGate {
    static constexpr bool PERM = true, AFTER_DRAIN = false, MIDK = false;
    bf16_t* G; const float* bg;
    __device__ __forceinline__ void operator()(const f32x4 (&acc)[2][2][4][2], const Unit& u, int wr, int wc, int fr, int fq) const {
        int rl0 = wr * 64 + fr, c8 = wc * 32 + 8 * fq; asm volatile("" : "+v"(rl0), "+v"(c8));
        const int ch = u.pn * 128 + c8;
        f32x4 bv[2][2];
#pragma unroll
        for (int bj = 0; bj < 2; ++bj) { bv[bj][0] = *(const f32x4*)(bg + bj * DM + ch); bv[bj][1] = *(const f32x4*)(bg + bj * DM + ch + 4); }
#pragma unroll
        for (int ai = 0; ai < 2; ++ai)
#pragma unroll
            for (int m = 0; m < 4; ++m) { const size_t R = (size_t)u.pm * 256 + ai * 128 + rl0 + 16 * m;
                f32x4 rt[2], g1[2];
#pragma unroll
                for (int n = 0; n < 2; ++n) { const f32x4 z0 = acc[ai][0][m][n] * (1.0f / WG_SCALE) + bv[0][n], z1 = acc[ai][1][m][n] * (1.0f / WG_SCALE) + bv[1][n];
#pragma unroll
                    for (int j = 0; j < 4; ++j) { const float e0 = 1.0f + __builtin_amdgcn_exp2f(-z0[j] * LOG2E), e1 = 1.0f + __builtin_amdgcn_exp2f(-z1[j] * LOG2E);
                        g1[n][j] = __builtin_amdgcn_rcpf(e1); rt[n][j] = e1 * __builtin_amdgcn_rcpf(e0); } }
                *(u32x4*)(G + R * (2 * DM) + ch) = pack8(rt[0], rt[1]); *(u32x4*)(G + R * (2 * DM) + DM + ch) = pack8(g1[0], g1[1]); }
    }
};
struct EpiMix {
    static constexpr bool PERM = true, AFTER_DRAIN = false, MIDK = true;
    const bf16_t* G; bf16_t* MG;
    __device__ __forceinline__ void mid(f32x4 (&acc)[2][2][4][2], const Unit& u, int wr, int wc, int fr, int fq) const {
        int cl = wc * 32 + 8 * fq, rl = wr * 64 + fr; asm volatile("" : "+v"(cl), "+v"(rl)); const int col0 = u.pn * 256 + cl;
#pragma unroll
        for (int ai = 0; ai < 2; ++ai)
#pragma unroll
            for (int mh = 0; mh < 2; ++mh) { u32x4 g0[2][2];
#pragma unroll
                for (int mm = 0; mm < 2; ++mm) { const size_t R = (size_t)u.pm * 256 + ai * 128 + 16 * (2 * mh + mm) + rl;
#pragma unroll
                    for (int bj = 0; bj < 2; ++bj) g0[mm][bj] = *(const u32x4*)(G + R * (2 * DM) + col0 + bj * 128); }
#pragma unroll
                for (int mm = 0; mm < 2; ++mm)
#pragma unroll
                    for (int bj = 0; bj < 2; ++bj) { const int m = 2 * mh + mm; f32x4 ga, gb; unpack8(g0[mm][bj], ga, gb);
                        acc[ai][bj][m][0] = acc[ai][bj][m][0] * ga; acc[ai][bj][m][1] = acc[ai][bj][m][1] * gb; } }
    }
    __device__ __forceinline__ void operator()(const f32x4 (&acc)[2][2][4][2], const Unit& u, int wr, int wc, int fr, int fq) const {
        int cl = wc * 32 + 8 * fq, rl = wr * 64 + fr; asm volatile("" : "+v"(cl), "+v"(rl)); const int col0 = u.pn * 256 + cl;
#pragma unroll
        for (int ai = 0; ai < 2; ++ai) { u32x4 g1[4][2];
#pragma unroll
            for (int m = 0; m < 4; ++m) { const size_t R = (size_t)u.pm * 256 + ai * 128 + 16 * m + rl;
#pragma unroll
                for (int bj = 0; bj < 2; ++bj) g1[m][bj] = *(const u32x4*)(G + R * (2 * DM) + DM + col0 + bj * 128); }
#pragma unroll
            for (int m = 0; m < 4; ++m) { const size_t R = (size_t)u.pm * 256 + ai * 128 + 16 * m + rl;
#pragma unroll
                for (int bj = 0; bj < 2; ++bj) { f32x4 ha, hb; unpack8(g1[m][bj], ha, hb);
                    *(u32x4*)(MG + R * DM + col0 + bj * 128) = pack8(ha * acc[ai][bj][m][0], hb * acc[ai][bj][m][1]); } } }
    }
};
struct EpiWo {
    static constexpr bool PERM = true, AFTER_DRAIN = false, MIDK = false;
    const float* x; bf16_t* H1; float* SS;
    __device__ __forceinline__ void operator()(const f32x4 (&acc)[2][2][4][2], const Unit& u, int wr, int wc, int fr, int fq) const {
        int cl = wc * 32 + 8 * fq, rl = wr * 64 + fr; asm volatile("" : "+v"(cl), "+v"(rl)); const int col0 = u.pn * 256 + cl;
#pragma unroll
        for (int ai = 0; ai < 2; ++ai)
#pragma unroll
            for (int mh = 0; mh < 2; ++mh) { f32x4 xv[2][2][2];
#pragma unroll
                for (int mm = 0; mm < 2; ++mm) { const size_t R = (size_t)u.pm * 256 + ai * 128 + 16 * (2 * mh + mm) + rl;
#pragma unroll
                    for (int bj = 0; bj < 2; ++bj) { const float* xp = x + R * DM + col0 + bj * 128; xv[mm][bj][0] = __builtin_nontemporal_load((const f32x4*)xp); xv[mm][bj][1] = __builtin_nontemporal_load((const f32x4*)(xp + 4)); } }
#pragma unroll
                for (int mm = 0; mm < 2; ++mm) { const int m = 2 * mh + mm; const size_t R = (size_t)u.pm * 256 + ai * 128 + 16 * m + rl; float s = 0.f;
#pragma unroll
                    for (int bj = 0; bj < 2; ++bj) { const f32x4 h0 = xv[mm][bj][0] + acc[ai][bj][m][0], h1 = xv[mm][bj][1] + acc[ai][bj][m][1];
                        *(u32x4*)(H1 + R * DM + col0 + bj * 128) = pack8(h0, h1);
                        s += dot4(h0) + dot4(h1); }
                    s += __shfl_xor(s, 16); s += __shfl_xor(s, 32);
                    if (fq == 0) atomicAdd(SS + R, s); } }
    }
};
struct EpiUp {
    static constexpr bool PERM = true, AFTER_DRAIN = false, MIDK = false;
    const float* SS; bf16_t* U;
    __device__ __forceinline__ void operator()(const f32x4 (&acc)[2][2][4][2], const Unit& u, int wr, int wc, int fr, int fq) const {
        int cl = wc * 32 + 8 * fq, rl = wr * 64 + fr; asm volatile("" : "+v"(cl), "+v"(rl)); const int col0 = u.pn * 256 + cl;
        float ssv[2][4];
#pragma unroll
        for (int ai = 0; ai < 2; ++ai)
#pragma unroll
            for (int m = 0; m < 4; ++m) ssv[ai][m] = SS[(size_t)u.pm * 256 + ai * 128 + 16 * m + rl];
#pragma unroll
        for (int ai = 0; ai < 2; ++ai)
#pragma unroll
            for (int m = 0; m < 4; ++m) { const size_t R = (size_t)u.pm * 256 + ai * 128 + 16 * m + rl;
                const float rstd = rsqrtf(ssv[ai][m] * (1.0f / DM) + EPS);
#pragma unroll
                for (int bj = 0; bj < 2; ++bj) { f32x4 v[2];
#pragma unroll
                    for (int n = 0; n < 2; ++n)
#pragma unroll
                        for (int j = 0; j < 4; ++j) { const float r = fmaxf(acc[ai][bj][m][n][j] * rstd, 0.f); v[n][j] = r * r; }
                    *(u32x4*)(U + R * DFF + col0 + bj * 128) = pack8(v[0], v[1]); } }
    }
};
struct EpiDown {
    static constexpr bool PERM = true, AFTER_DRAIN = false, MIDK = false;
    const bf16_t* H1; float* out;
    __device__ __forceinline__ void operator()(const f32x4 (&acc)[2][2][4][2], const Unit& u, int wr, int wc, int fr, int fq) const {
        int cl = wc * 32 + 8 * fq, rl = wr * 64 + fr; asm volatile("" : "+v"(cl), "+v"(rl)); const int col0 = u.pn * 256 + cl;
#pragma unroll
        for (int ai = 0; ai < 2; ++ai) { u32x4 hv[4][2];
#pragma unroll
            for (int m = 0; m < 4; ++m) { const size_t R = (size_t)u.pm * 256 + ai * 128 + 16 * m + rl;
#pragma unroll
                for (int bj = 0; bj < 2; ++bj) hv[m][bj] = *(const u32x4*)(H1 + R * DM + col0 + bj * 128); }
#pragma unroll
            for (int m = 0; m < 4; ++m) { const size_t R = (size_t)u.pm * 256 + ai * 128 + 16 * m + rl;
#pragma unroll
                for (int bj = 0; bj < 2; ++bj) { const size_t off = R * DM + col0 + bj * 128;
                    f32x4 ha, hb; unpack8(hv[m][bj], ha, hb);
                    *(f32x4*)(out + off) = ha + acc[ai][bj][m][0]; *(f32x4*)(out + off + 4) = hb + acc[ai][bj][m][1]; } } }
    }
};

template <class Epi, class Sched, bool ALIGN_EPI = false, bool SP2 = false, bool FP8 = false>
__device__ __forceinline__ void gemm_phase(PG8_LAS unsigned char* lds, const Gemm g, const Sched& S, const Epi& E, const int wave_u) {
    const int wid = wave_u, lane = lane_now(), tid = wid * 64 + lane, wr = wid >> 2, wc = wid & 3, fr = lane & 15, fq = lane >> 4;
    const int K = g.K, nt = K / BK, ld = g.ld;
    unsigned voffA[2], voffB[2];
#pragma unroll
    for (int i = 0; i < 2; ++i) { int R, C; stage_rc(tid * 16 + i * 8192, R, C); const int Rb = Epi::PERM ? ((R & ~31) + perm32(R & 31)) : R;
        voffA[i] = (unsigned)(R * ld + C) * 2u; voffB[i] = (unsigned)(Rb * ld + C) * 2u; }
    const size_t kstep = (size_t)(BK * 2);
    const size_t hstep = (size_t)HALF * ld * 2;
    const size_t tstep = 2 * hstep;
    const unsigned ldsw = (unsigned)wid * 1024u;
    const int aoff = lds_byte(wr * 64 + fr, fq * 8), boff = lds_byte(wc * 32 + fr, fq * 8);
#define PG8_SA(b, h) (((b) * 2 + (h)) * HTB)
#define PG8_SB(b, h) ((4 + (b) * 2 + (h)) * HTB)
#define PG8_STAGE(bufoff, gbase, voff) do { const char* gb_ = (const char*)(gbase); asm volatile("" : "+s"(gb_));     \
        _Pragma("unroll") for (int _i = 0; _i < 2; ++_i) { unsigned vo_ = (voff)[_i]; asm volatile("" : "+v"(vo_)); \
        __builtin_amdgcn_global_load_lds((const unsigned*)(gb_ + vo_), (PG8_LAS unsigned*)(lds + (bufoff) + ldsw + _i * 8192), 16, 0, 0); } } while (0)
#define PG8_F8(lo, hi) __builtin_shufflevector(__builtin_bit_cast(i32x4, lo), __builtin_bit_cast(i32x4, hi), 0, 1, 2, 3, 4, 5, 6, 7)
#define PG8_LDA(dst, b, h) do { _Pragma("unroll") for (int m = 0; m < 4; ++m) { const PG8_LAS bf16x8* p_ = (const PG8_LAS bf16x8*)(lds + PG8_SA(b, h) + aoff + m * 2048); \
        if constexpr (FP8) dst##8[m] = PG8_F8(p_[0], p_[64]); else { dst[m][0] = p_[0]; dst[m][1] = p_[64]; } } } while (0)
#define PG8_LDB(dst, b, h) do { _Pragma("unroll") for (int n = 0; n < 2; ++n) { const PG8_LAS bf16x8* p_ = (const PG8_LAS bf16x8*)(lds + PG8_SB(b, h) + boff + n * 2048); \
        if constexpr (FP8) dst##8[n] = PG8_F8(p_[0], p_[64]); else { dst[n][0] = p_[0]; dst[n][1] = p_[64]; } } } while (0)
#define PG8_MMA(ai, bj, At, Bt) do { __builtin_amdgcn_s_setprio(1); \
        if constexpr (FP8) { _Pragma("unroll") for (int m = 0; m < 4; ++m) _Pragma("unroll") for (int n = 0; n < 2; ++n) \
            acc[ai][bj][m][n] = __builtin_amdgcn_mfma_scale_f32_16x16x128_f8f6f4(Bt##8[n], At##8[m], acc[ai][bj][m][n], 0, 0, 0, 0x7f7f7f7f, 0, 0x7f7f7f7f); } \
        else { _Pragma("unroll") for (int k = 0; k < 2; ++k) _Pragma("unroll") for (int m = 0; m < 4; ++m) _Pragma("unroll") for (int n = 0; n < 2; ++n)     \
            acc[ai][bj][m][n] = __builtin_amdgcn_mfma_f32_16x16x32_bf16(Bt[n][k], At[m][k], acc[ai][bj][m][n], 0, 0, 0); } \
        __builtin_amdgcn_s_setprio(0); } while (0)
#define PG8_WAIT_V(n) asm volatile("s_waitcnt vmcnt(" #n ")" ::: "memory")
#define PG8_WAIT_L(n) asm volatile("s_waitcnt lgkmcnt(" #n ")" ::: "memory")
#define PG8_BAR __builtin_amdgcn_s_barrier()
#define PG8_SCHED __builtin_amdgcn_sched_barrier(0)
    Unit cur, nxt; int ui = 0;
    if (!S.next(0, cur)) return;
    f32x4 acc[2][2][4][2];
#pragma unroll
    for (int a = 0; a < 2; ++a)
#pragma unroll
        for (int b = 0; b < 2; ++b)
#pragma unroll
            for (int m = 0; m < 4; ++m)
#pragma unroll
                for (int n = 0; n < 2; ++n) acc[a][b][m][n] = (f32x4){0.f, 0.f, 0.f, 0.f};
    bf16x8 At[4][2], B0[2][2], B1[2][2];
    i32x8 At8[4], B08[2], B18[2];
    const char* cA = (const char*)g.A + (size_t)cur.pm * tstep + (size_t)cur.ko * 2; const char* cB = (const char*)g.Bt + (size_t)cur.pn * tstep + (size_t)cur.ko * 2;
    if constexpr (SP2) {
        PG8_STAGE(PG8_SB(0, 0), cB, voffB); PG8_STAGE(PG8_SB(0, 1), cB + hstep, voffB); PG8_STAGE(PG8_SA(0, 0), cA, voffA); PG8_STAGE(PG8_SA(0, 1), cA + hstep, voffA);
        if (wr == 1) PG8_BAR;
        PG8_WAIT_V(2); PG8_BAR;
        PG8_STAGE(PG8_SB(1, 0), cB + kstep, voffB); PG8_STAGE(PG8_SA(1, 0), cA + kstep, voffA); PG8_STAGE(PG8_SB(1, 1), cB + hstep + kstep, voffB);
        PG8_WAIT_V(6); PG8_BAR;
    } else {
        PG8_STAGE(PG8_SB(0, 0), cB, voffB); PG8_STAGE(PG8_SA(0, 0), cA, voffA); PG8_STAGE(PG8_SB(0, 1), cB + hstep, voffB); PG8_STAGE(PG8_SA(0, 1), cA + hstep, voffA);
        if (wr == 1) PG8_BAR;
        PG8_WAIT_V(4); PG8_BAR;
        PG8_STAGE(PG8_SB(1, 0), cB + kstep, voffB); PG8_STAGE(PG8_SA(1, 0), cA + kstep, voffA); PG8_STAGE(PG8_SB(1, 1), cB + hstep + kstep, voffB);
        PG8_WAIT_V(6); PG8_BAR;
    }
    for (;;) {
        const bool has_next = S.next(ui + 1, nxt);
        const char* nA = has_next ? (const char*)g.A + (size_t)nxt.pm * tstep + (size_t)nxt.ko * 2 : cA; const char* nB = has_next ? (const char*)g.Bt + (size_t)nxt.pn * tstep + (size_t)nxt.ko * 2 : cB;
        for (int t = 0; t < nt; t += 2) {
            const bool last = (t == nt - 2);
            const char* a1 = cA + (size_t)(t + 1) * kstep;
            const char* a2 = last ? nA : cA + (size_t)(t + 2) * kstep; const char* b2 = last ? nB : cB + (size_t)(t + 2) * kstep;
            const char* a3 = a2 + kstep; const char* b3 = b2 + kstep;
            if constexpr (Epi::MIDK) { if (t == (nt >> 1)) E.mid(acc, cur, wr, wc, fr, fq); }
            if constexpr (SP2) {
            PG8_STAGE(PG8_SA(1, 1), a1 + hstep, voffA); PG8_SCHED; PG8_LDB(B0, 0, 0); PG8_LDB(B1, 0, 1); PG8_SCHED; PG8_LDA(At, 0, 0);
            PG8_WAIT_V(8); PG8_WAIT_L(0); PG8_BAR; PG8_MMA(0, 0, At, B0); PG8_MMA(0, 1, At, B1); PG8_BAR; PG8_SCHED;
            PG8_STAGE(PG8_SB(0, 0), b2, voffB); PG8_STAGE(PG8_SB(0, 1), b2 + hstep, voffB); PG8_STAGE(PG8_SA(0, 0), a2, voffA); PG8_SCHED; PG8_LDA(At, 0, 1);
            PG8_WAIT_V(8); PG8_WAIT_L(0); PG8_BAR; PG8_MMA(1, 0, At, B0); PG8_MMA(1, 1, At, B1); PG8_BAR; PG8_SCHED;
            PG8_STAGE(PG8_SA(0, 1), a2 + hstep, voffA); PG8_SCHED; PG8_LDB(B0, 1, 0); PG8_LDB(B1, 1, 1); PG8_SCHED; PG8_LDA(At, 1, 0);
            PG8_WAIT_V(8); PG8_WAIT_L(0); PG8_BAR; PG8_MMA(0, 0, At, B0); PG8_MMA(0, 1, At, B1); PG8_BAR; PG8_SCHED;
            PG8_STAGE(PG8_SB(1, 0), b3, voffB); PG8_STAGE(PG8_SB(1, 1), b3 + hstep, voffB); PG8_STAGE(PG8_SA(1, 0), a3, voffA); PG8_SCHED; PG8_LDA(At, 1, 1);
            PG8_WAIT_V(8); PG8_WAIT_L(0); PG8_BAR; PG8_MMA(1, 0, At, B0); PG8_MMA(1, 1, At, B1); PG8_BAR; PG8_SCHED;
            } else {
            PG8_LDB(B0, 0, 0); PG8_SCHED; PG8_LDA(At, 0, 0); PG8_STAGE(PG8_SA(1, 1), a1 + hstep, voffA);
            PG8_WAIT_L(8); PG8_BAR; PG8_WAIT_L(0); PG8_MMA(0, 0, At, B0); PG8_BAR; PG8_SCHED;
            PG8_LDB(B1, 0, 1); PG8_STAGE(PG8_SB(0, 0), b2, voffB);
            PG8_BAR; PG8_WAIT_L(0); PG8_MMA(0, 1, At, B1); PG8_BAR;
            PG8_LDA(At, 0, 1); PG8_STAGE(PG8_SA(0, 0), a2, voffA);
            PG8_BAR; PG8_WAIT_L(0); PG8_MMA(1, 0, At, B0); PG8_BAR; PG8_SCHED;
            PG8_STAGE(PG8_SB(0, 1), b2 + hstep, voffB);
            PG8_WAIT_V(6); PG8_BAR; PG8_MMA(1, 1, At, B1); PG8_BAR;
            PG8_LDB(B0, 1, 0); PG8_SCHED; PG8_LDA(At, 1, 0); PG8_STAGE(PG8_SA(0, 1), a2 + hstep, voffA);
            PG8_WAIT_L(8); PG8_BAR; PG8_WAIT_L(0); PG8_MMA(0, 0, At, B0); PG8_BAR; PG8_SCHED;
            PG8_LDB(B1, 1, 1); PG8_STAGE(PG8_SB(1, 0), b3, voffB);
            PG8_BAR; PG8_WAIT_L(0); PG8_MMA(0, 1, At, B1); PG8_BAR;
            PG8_LDA(At, 1, 1); PG8_STAGE(PG8_SA(1, 0), a3, voffA);
            PG8_BAR; PG8_WAIT_L(0); PG8_MMA(1, 0, At, B0); PG8_BAR; PG8_SCHED;
            PG8_STAGE(PG8_SB(1, 1), b3 + hstep, voffB);
            PG8_WAIT_V(6); PG8_BAR; PG8_MMA(1, 1, At, B1); PG8_BAR;
            }
        }
        if constexpr (ALIGN_EPI) { if (wr == 0) PG8_BAR; }
        { const int l2 = lane_now(); E(acc, cur, wid >> 2, wid & 3, l2 & 15, l2 >> 4); }
        if (!has_next) break;
#pragma unroll
        for (int a = 0; a < 2; ++a)
#pragma unroll
            for (int b = 0; b < 2; ++b)
#pragma unroll
                for (int m = 0; m < 4; ++m)
#pragma unroll
                    for (int n = 0; n < 2; ++n) acc[a][b][m][n] = (f32x4){0.f, 0.f, 0.f, 0.f};
        cur = nxt; cA = nA; cB = nB; ++ui;
        if constexpr (ALIGN_EPI) { if (wr == 1) PG8_BAR; }
    }
    PG8_WAIT_V(0);
    if constexpr (!ALIGN_EPI) { if (wr == 0) PG8_BAR; }
    PG8_BAR;
#undef PG8_SA
#undef PG8_SB
#undef PG8_STAGE
#undef PG8_LDA
#undef PG8_LDB
#undef PG8_MMA
#undef PG8_F8
#undef PG8_WAIT_V
#undef PG8_WAIT_L
#undef PG8_BAR
#undef PG8_SCHED
}
}

namespace fa {
using bf16 = __hip_bfloat16;
typedef short bf16x8 __attribute__((ext_vector_type(8)));
typedef short s16x4 __attribute__((ext_vector_type(4)));
typedef float f32x16 __attribute__((ext_vector_type(16)));
typedef float f32x4 __attribute__((ext_vector_type(4)));
typedef unsigned u32x4 __attribute__((ext_vector_type(4)));
constexpr int D = 128, NW = 8, QBLK = 32, KVBLK = 64, QB = NW * QBLK;
constexpr int SHM_V = KVBLK * D * 2, SHM_K = KVBLK * D * 2;
constexpr int LDS_WS = 2 * SHM_V + 2 * SHM_K;
constexpr int LDS_FB = LDS_WS + NW * 64 * 4;
constexpr int LDS_SCAN = LDS_FB + LP * 4;
constexpr int LDS_BYTES = LDS_SCAN + 64;
constexpr int OP = 2 * AW;
constexpr float THR = 16.f;
constexpr unsigned WBIG = 1u << 24;

#define KSWZ(row, colB) ((row) * 256 + ((colB) ^ (((row) & 7) << 4)))
#define SBAR() __builtin_amdgcn_sched_barrier(0)
__device__ __forceinline__ int v_st(int k, int c) { const int kk = (k & ~0xC) | ((k & 4) << 1) | ((k & 8) >> 1); return ((kk >> 3) * 4 + (c >> 5)) * 512 + ((kk & 7) * 32 + (c & 31)) * 2; }
__device__ __forceinline__ int v_rd_base(int lane) { return ((lane & 3) << 3) | (((lane >> 2) & 3) << 6) | (((lane >> 4) & 1) << 5) | (((lane >> 5) & 1) << 8); }
constexpr int v_rd_off(int d0, int ks, int half) { return d0 * 512 + ks * 4096 + half * 2048; }
__device__ __forceinline__ int crow(int r, int hi) { return (r & 3) + 8 * (r >> 2) + 4 * hi; }
__device__ __forceinline__ unsigned cvtpk(float lo, float hi) { return pg8::cvt_pk_bf16(lo, hi); }
#define FA_GAS __attribute__((address_space(1)))
#define FA_LAS __attribute__((address_space(3)))
typedef const FA_GAS bf16* gcp;
typedef FA_GAS bf16* gp;
__device__ __forceinline__ bf16x8 load8(gcp p) { return *(const FA_GAS bf16x8*)p; }
__device__ __forceinline__ void mask_tile(f32x16& p0, f32x16& p1, int dq, unsigned W) {
    const float NEG = -__builtin_inff();
#pragma unroll
    for (int r = 0; r < 16; ++r) {
        const int c = (r & 3) + 8 * (r >> 2);
        if ((unsigned)(dq - c) >= W) p0[r] = NEG;
        if ((unsigned)(dq - c - 32) >= W) p1[r] = NEG;
    }
}
__device__ __forceinline__ void partialSM(f32x16& p0, f32x16& p1, float& m_reg, float& mn, float& alpha) {
    float pmax = p0[0]; for (int r = 1; r < 16; ++r) pmax = fmaxf(pmax, p0[r]); for (int r = 0; r < 16; ++r) pmax = fmaxf(pmax, p1[r]);
    { auto rr = __builtin_amdgcn_permlane32_swap(__float_as_uint(pmax), __float_as_uint(pmax), false, false);
      pmax = fmaxf(__uint_as_float(rr[0]), __uint_as_float(rr[1])); }
    if (__builtin_expect(__all((pmax - m_reg) <= THR), 1)) { mn = m_reg; alpha = 1.f; }
    else { mn = fmaxf(m_reg, pmax); alpha = __builtin_amdgcn_exp2f(m_reg - mn); m_reg = mn; }
    for (int r = 0; r < 16; ++r) p0[r] = p0[r] - mn; for (int r = 0; r < 16; ++r) p1[r] = p1[r] - mn;
    for (int r = 0; r < 16; ++r) p0[r] = __builtin_amdgcn_exp2f(p0[r]);
}
__device__ __forceinline__ void finishSM(f32x16& p0, f32x16& p1, float alpha, float& l_reg, bf16x8& pa0, bf16x8& pa1, bf16x8& pa2, bf16x8& pa3) {
    for (int r = 0; r < 16; ++r) p1[r] = __builtin_amdgcn_exp2f(p1[r]);
    float ps = 0; for (int r = 0; r < 16; ++r) ps += p0[r]; for (int r = 0; r < 16; ++r) ps += p1[r];
    { auto rr = __builtin_amdgcn_permlane32_swap(__float_as_uint(ps), __float_as_uint(ps), false, false);
      ps = __uint_as_float(rr[0]) + __uint_as_float(rr[1]); }
    l_reg = l_reg * alpha + ps;
#define PK4(P, B_, OUT) do { unsigned a0 = cvtpk(P[B_+0], P[B_+1]), a1 = cvtpk(P[B_+2], P[B_+3]);                          \
        unsigned b0 = cvtpk(P[B_+4], P[B_+5]), b1 = cvtpk(P[B_+6], P[B_+7]);                                             \
        auto r0 = __builtin_amdgcn_permlane32_swap(a0, b0, false, false); auto r1 = __builtin_amdgcn_permlane32_swap(a1, b1, false, false); \
        u32x4 w = {r0[0], r1[0], r0[1], r1[1]}; OUT = *reinterpret_cast<bf16x8*>(&w); } while (0)
    PK4(p0, 0, pa0); PK4(p0, 8, pa1); PK4(p1, 0, pa2); PK4(p1, 8, pa3);
#undef PK4
}
template <int KB>
__device__ __forceinline__ void qkt(f32x16& p0, f32x16& p1, const char* K_lds, const FA_LAS float* fb, int r32, int hi, const bf16x8* qr) {
#pragma unroll
    for (int g = 0; g < 4; ++g) { const f32x4 a = *(const FA_LAS f32x4*)(fb + 8 * g), b = *(const FA_LAS f32x4*)(fb + 32 + 8 * g);
        p0[4 * g] = a[0]; p0[4 * g + 1] = a[1]; p0[4 * g + 2] = a[2]; p0[4 * g + 3] = a[3];
        p1[4 * g] = b[0]; p1[4 * g + 1] = b[1]; p1[4 * g + 2] = b[2]; p1[4 * g + 3] = b[3]; }
    const char* kb[4];
#pragma unroll
    for (int dd = 0; dd < 4; ++dd) kb[dd] = K_lds + KB * SHM_K + KSWZ(r32, (dd * 16 + hi * 8) * 2);
#pragma unroll
    for (int d0 = 0; d0 < 8; ++d0) { const char* a = kb[d0 & 3] + (d0 >> 2) * 128;
        bf16x8 b0 = *reinterpret_cast<const bf16x8*>(a);
        bf16x8 b1 = *reinterpret_cast<const bf16x8*>(a + 32 * 256);
        p0 = __builtin_amdgcn_mfma_f32_32x32x16_bf16(b0, qr[d0], p0, 0, 0, 0);
        p1 = __builtin_amdgcn_mfma_f32_32x32x16_bf16(b1, qr[d0], p1, 0, 0, 0); }
}
template <int VB>
__device__ __forceinline__ void pv_tile(f32x16* o, int vb0, bf16x8 pa0, bf16x8 pa1, bf16x8 pa2, bf16x8 pa3) {
#define TRRD(dst, off) asm volatile("ds_read_b64_tr_b16 %0, %1 offset:%2" : "=&v"(dst) : "v"(vb0), "i"(off) : "memory")
#define PV_D0(d0) do { s16x4 l0, l1, l2, l3, h0, h1, h2, h3; constexpr int b_ = VB * SHM_V + v_rd_off(d0, 0, 0); \
        TRRD(l0, b_); TRRD(h0, b_ + 2048); TRRD(l1, b_ + 4096); TRRD(h1, b_ + 6144); TRRD(l2, b_ + 8192); TRRD(h2, b_ + 10240); TRRD(l3, b_ + 12288); TRRD(h3, b_ + 14336); \
        asm volatile("s_waitcnt lgkmcnt(0)" ::: "memory"); SBAR();   \
        o[d0] = __builtin_amdgcn_mfma_f32_32x32x16_bf16(pa0, (bf16x8){l0[0], l0[1], l0[2], l0[3], h0[0], h0[1], h0[2], h0[3]}, o[d0], 0, 0, 0);   \
        o[d0] = __builtin_amdgcn_mfma_f32_32x32x16_bf16(pa1, (bf16x8){l1[0], l1[1], l1[2], l1[3], h1[0], h1[1], h1[2], h1[3]}, o[d0], 0, 0, 0);   \
        o[d0] = __builtin_amdgcn_mfma_f32_32x32x16_bf16(pa2, (bf16x8){l2[0], l2[1], l2[2], l2[3], h2[0], h2[1], h2[2], h2[3]}, o[d0], 0, 0, 0);   \
        o[d0] = __builtin_amdgcn_mfma_f32_32x32x16_bf16(pa3, (bf16x8){l3[0], l3[1], l3[2], l3[3], h3[0], h3[1], h3[2], h3[3]}, o[d0], 0, 0, 0); } while (0)
    PV_D0(0); PV_D0(1); PV_D0(2); PV_D0(3);
#undef PV_D0
#undef TRRD
}

struct BlockRef { gcp Q; gcp K; gcp V; gp O; int P0; int jlo; };
struct Seam { bf16x8 qr[8]; bf16x8 st_v0, st_v1, st_k0, st_k1; };
#define ROW(p, k0, rr) ((p) + (size_t)((k0) + (rr)) * D + sc)
#define VMW() asm volatile("s_waitcnt vmcnt(0)" ::: "memory")
#define VMWN(n) asm volatile("s_waitcnt vmcnt(%0)" :: "i"(n) : "memory")
#define SLOAD_H(Kp, Vp, k0) do { S.st_v0 = load8(ROW(Vp, k0, sr)); S.st_v1 = load8(ROW(Vp, k0, 32 + sr));              \
                         S.st_k0 = load8(ROW(Kp, k0, sr)); S.st_k1 = load8(ROW(Kp, k0, 32 + sr)); } while (0)
#define SWRITE_HK(bf) do { *(bf16x8*)(K_lds + (bf) * SHM_K + kws) = S.st_k0; *(bf16x8*)(K_lds + (bf) * SHM_K + kws + 32 * 256) = S.st_k1; } while (0)
#define SWRITE_HV(bf) do { *(bf16x8*)(V_lds + (bf) * SHM_V + vst0) = S.st_v0; *(bf16x8*)(V_lds + (bf) * SHM_V + vst1) = S.st_v1; } while (0)
#define SWRITE_H(bf) do { SWRITE_HV(bf); SWRITE_HK(bf); } while (0)
__device__ __forceinline__ void fox_prime(const BlockRef& cur, char* lds, Seam& S, const int wave_u, const int lane) {
    const int wid = wave_u, tid = wid * 64 + lane, r32 = lane & 31, hi = lane >> 5;
    const int sr = tid >> 4, sc = (tid & 15) * 8, kws = KSWZ(sr, sc * 2); char* K_lds = lds + 2 * SHM_V;
    for (int d0 = 0; d0 < 8; ++d0) S.qr[d0] = load8(cur.Q + (size_t)(wid * QBLK + r32) * D + d0 * 16 + hi * 8);
    SLOAD_H(cur.K, cur.V, cur.jlo * KVBLK); VMW(); SWRITE_HK(0);
    __syncthreads();
}
__device__ __forceinline__ void fox_block(const BlockRef& cur, const BlockRef& nxt, char* lds, Seam& S, const int wave_u, const int lane) {
    const int wid = wave_u, tid = wid * 64 + lane, r32 = lane & 31, hi = lane >> 5;
    const int j_lo = cur.jlo, NT = (cur.P0 + QB - 1) / KVBLK + 1 - j_lo;
    const int kbn = nxt.jlo * KVBLK;
    const int qlo = cur.P0 + wid * QBLK, qm = qlo + r32 - 4 * hi;
    char* V_lds = lds; char* K_lds = lds + 2 * SHM_V;
    float* ws = (float*)(lds + LDS_WS) + wid * 64; float* li_l = ws, * al_l = ws + 32;
    const FA_LAS float* fbh = (const FA_LAS float*)((FA_LAS char*)lds + LDS_FB) + 4 * hi;
    float m_reg = -1e30f, l_reg = 0; f32x16 o[4] = {};
    const int sr = tid >> 4, sc = (tid & 15) * 8, vst0 = v_st(sr, sc), vst1 = vst0 + 8192  , kws = KSWZ(sr, sc * 2);
    const int vb0 = (int)(uintptr_t)V_lds + v_rd_base(lane);
    const gcp Kh = cur.K; const gcp Vh = cur.V;
#define RESC(a) do { if (__any((a) < 1.f)) { if (hi == 0) al_l[r32] = (a); asm volatile("s_waitcnt lgkmcnt(0)" ::: "memory");              \
                     for (int d_ = 0; d_ < 4; ++d_) for (int r = 0; r < 16; ++r) o[d_][r] *= al_l[crow(r, hi)]; } } while (0)
#define KBASE(t) ((j_lo + (t)) * KVBLK)
#define MASKT(P0_, P1_, t) do { const int kb_ = KBASE(t); if (kb_ + KVBLK - 1 > qlo) mask_tile(P0_, P1_, qm - kb_, WBIG); } while (0)
    constexpr int NQL = 8;
#define SEAM_K0() do { VMWN(NQL); SWRITE_HK(0); SBAR(); } while (0)
    f32x16 pA0, pA1, pB0, pB1; float mnA, mnB, alA, alB; bf16x8 pa0, pa1, pa2, pa3;
    SWRITE_HV(0); SBAR();
    if (NT > 1) { SLOAD_H(Kh, Vh, KBASE(1)); }
    SBAR(); qkt<0>(pA0, pA1, K_lds, fbh + KBASE(0), r32, hi, S.qr);
    MASKT(pA0, pA1, 0); partialSM(pA0, pA1, m_reg, mnA, alA);
    if (NT > 1) { VMW(); SWRITE_H(1); }
    __syncthreads();
#define HALF_STEP(PX0, PX1, mnX, alX, PY0, PY1, alY, t, KB, VB, SB) do {                                                      \
        SBAR(); qkt<KB>(PX0, PX1, K_lds, fbh + KBASE(t), r32, hi, S.qr);                                         \
        finishSM(PY0, PY1, alY, l_reg, pa0, pa1, pa2, pa3); SBAR();                                                           \
        if ((t) + 1 < NT) { SLOAD_H(Kh, Vh, KBASE((t) + 1)); SBAR(); }                                               \
        pv_tile<VB>(o, vb0, pa0, pa1, pa2, pa3); MASKT(PX0, PX1, (t)); partialSM(PX0, PX1, m_reg, mnX, alX);                                        \
        __syncthreads();                                                                                                      \
        if ((t) + 1 < NT) { VMW(); SWRITE_H(SB); }                                                                          \
        RESC(alX); __syncthreads(); } while (0)
    for (int t = 1; t + 1 < NT; t += 2) {
        HALF_STEP(pB0, pB1, mnB, alB, pA0, pA1, alA, t, 1, 0, 0);
        HALF_STEP(pA0, pA1, mnA, alA, pB0, pB1, alB, t + 1, 0, 1, 1);
    }
    const bool even = (NT & 1) == 0;
    if (even) { SBAR(); qkt<1>(pB0, pB1, K_lds, fbh + KBASE(NT - 1), r32, hi, S.qr); SBAR(); }
    SLOAD_H(nxt.K, nxt.V, kbn); SBAR();
#pragma unroll
    for (int d0 = 0; d0 < 8; ++d0) S.qr[d0] = load8(nxt.Q + (size_t)(wid * QBLK + r32) * D + d0 * 16 + hi * 8);
    SBAR();
    finishSM(pA0, pA1, alA, l_reg, pa0, pa1, pa2, pa3); SBAR();
    pv_tile<0>(o, vb0, pa0, pa1, pa2, pa3);
    if (even) { MASKT(pB0, pB1, NT - 1); partialSM(pB0, pB1, m_reg, mnB, alB); __syncthreads(); RESC(alB);
        finishSM(pB0, pB1, alB, l_reg, pa0, pa1, pa2, pa3); SBAR(); pv_tile<1>(o, vb0, pa0, pa1, pa2, pa3); }
    SBAR(); SEAM_K0();
    if (hi == 0) li_l[r32] = l_reg; asm volatile("s_waitcnt lgkmcnt(0)" ::: "memory");
    float rli[16];
#pragma unroll
    for (int r = 0; r < 16; ++r) rli[r] = __builtin_amdgcn_rcpf(li_l[crow(r, hi)]);
    const gp Ow = cur.O + (size_t)(wid * QBLK) * OP;
#pragma unroll
    for (int r = 0; r < 16; ++r) { const int orow = crow(r, hi);
#pragma unroll
        for (int d0 = 0; d0 < 4; ++d0) { const float v = o[d0][r] * rli[r];
            const float vn = __shfl_xor(v, 1);
            if ((r32 & 1) == 0) *(FA_GAS unsigned*)(Ow + (size_t)orow * OP + d0 * 32 + r32) = cvtpk(v, vn); } }
    __syncthreads();
#undef RESC
#undef KBASE
#undef MASKT
#undef SEAM_K0
#undef HALF_STEP
}
#undef ROW
#undef VMW
#undef VMWN
#undef SLOAD_H
#undef SWRITE_HK
#undef SWRITE_HV
#undef SWRITE_H
#undef KSWZ
#undef SBAR
}

constexpr int NWAVES = 8, NTHREADS = 512;
constexpr int N_LAUNCHES = MK_N_LAUNCHES;
constexpr int N_PHASES = 7;
constexpr size_t MiB = 1u << 20;
constexpr size_t WS_SS = 0;
constexpr size_t WS_MRS = 48 * 1024;
constexpr size_t WS_BAR = 64 * 1024;
constexpr size_t WS_LF = 1 * MiB;
constexpr size_t WS_MACC = WS_LF + 512 * 1024;
constexpr size_t WS_WUP = 4 * MiB, WS_WDN = 36 * MiB, WS_WO = 68 * MiB, WS_WMIX = 76 * MiB;
constexpr size_t WS_WIN = 84 * MiB;
constexpr size_t WS_XN = 124 * MiB;
constexpr size_t WS_ACAT = WS_XN;
constexpr size_t WS_Q = 156 * MiB, WS_K = 172 * MiB, WS_V = 189 * MiB;
constexpr size_t WS_MG = WS_Q;
constexpr size_t WS_UB = 206 * MiB, WS_CB = 223 * MiB, WS_G = 239 * MiB;
constexpr size_t WS_H1G = WS_G;
constexpr size_t WS_XN8 = WS_WUP;
constexpr size_t WS_WG8 = WS_WDN;
constexpr size_t WS_UU = WS_WIN;
constexpr size_t WS_END = 303 * MiB;
static_assert(WS_UU + (size_t)MROWS * DFF * 2 <= WS_G && WS_K + (size_t)NB * NH * LP * HD * 2 <= WS_V && WS_V + (size_t)NB * NH * LP * HD * 2 <= WS_UB &&
              WS_UB + (size_t)NB * UBR * CW * 2 <= WS_CB && WS_G + (size_t)MROWS * 2 * DM * 2 <= WS_END && WS_MG + (size_t)MROWS * DM * 2 <= WS_V, "d_ws map");
constexpr int RING_BYTES = 131072, SCR_OFF = RING_BYTES, LDS_BYTES = 147456;
static_assert(fa::LDS_BYTES <= RING_BYTES, "attention LDS");

#define LAS __attribute__((address_space(3)))
typedef unsigned short bf16;
typedef unsigned v4u __attribute__((ext_vector_type(4)));
typedef float f32x4 __attribute__((ext_vector_type(4)));
__device__ __forceinline__ unsigned f2bf(float f) { unsigned u = __builtin_bit_cast(unsigned, f); return (u + 0x7fffu + ((u >> 16) & 1u)) >> 16; }
__device__ __forceinline__ unsigned pk2(float lo, float hi) { return pg8::cvt_pk_bf16(lo, hi); }
__device__ __forceinline__ float wave_sum(float v) {
#pragma unroll
    for (int o = 1; o < 64; o <<= 1) v += __shfl_xor(v, o);
    return v;
}


#define XB_TMO      128
#define XB_XCNT(j)  (256  + 64 * (j))
#define XB_XSUB(j)  (1280 + 64 * (j))
#define XB_XGEN(j)  (2304 + 64 * (j))
#define XB_TOP      3328
#define XB_TOPGEN   3392
#define XCD_BAR_WORDS 3456
#define XB_SPIN_CAP (1u << 22)
__device__ __forceinline__ unsigned xb_ld(unsigned* p)              { return __hip_atomic_load(p, __ATOMIC_RELAXED, __HIP_MEMORY_SCOPE_AGENT); }
__device__ __forceinline__ unsigned xb_add(unsigned* p, unsigned v) { return __hip_atomic_fetch_add(p, v, __ATOMIC_RELAXED, __HIP_MEMORY_SCOPE_AGENT); }
__device__ __forceinline__ unsigned xb_xcc_id() { return (unsigned)__builtin_amdgcn_s_getreg((3 << 11) | 20) & 0xFu; }
#define XB_SPIN(cond, bar) do { unsigned _sp = 0; while (cond) { __builtin_amdgcn_s_sleep(4); \
    if ((++_sp & 255u) == 0u) { if (xb_ld(&(bar)[XB_TMO])) break; if (_sp > XB_SPIN_CAP) { atomicAdd(&(bar)[XB_TMO], 1u); break; } } } } while (0)
struct XcdBarrier { unsigned* bar; unsigned x; volatile LAS unsigned* st; };
__device__ __forceinline__ XcdBarrier xcd_barrier_post(unsigned* bar, volatile LAS unsigned* st, bool leader) {
    XcdBarrier b; b.bar = bar; b.x = xb_xcc_id(); b.st = st;
    if (leader) (void)xb_add(&bar[XB_XCNT(b.x)], 1u);
    return b;
}
__device__ __forceinline__ void xcd_barrier_complete(unsigned* bar, unsigned x, unsigned& nloc, unsigned& nx) {
    const unsigned G = gridDim.x * gridDim.y * gridDim.z;
    unsigned sum, cnt, mine, sp = 0u;
    for (;;) {
        sum = 0u; cnt = 0u; mine = 0u;
#pragma unroll
        for (unsigned j = 0; j < 16; ++j) { const unsigned c = xb_ld(&bar[XB_XCNT(j)]); sum += c; cnt += (c > 0u) ? 1u : 0u; mine = (j == x) ? c : mine; }
        if (sum == G) break;
        __builtin_amdgcn_s_sleep(1);
        if ((++sp & 255u) == 0u) { if (xb_ld(&bar[XB_TMO])) break; if (sp > XB_SPIN_CAP) { atomicAdd(&bar[XB_TMO], 1u); break; } }
    }
    nloc = mine > 0u ? mine : 1u; nx = cnt > 0u ? cnt : 1u;
}
__device__ __forceinline__ void xcd_barrier(const XcdBarrier& b, bool leader) {
    asm volatile("s_waitcnt vmcnt(0)" ::: "memory");
    __syncthreads();
    if (leader) {
        unsigned* bar = b.bar;
        __builtin_amdgcn_s_waitcnt(0);
        unsigned nloc = b.st[0], nx = b.st[1];
        if (nloc == 0u) { xcd_barrier_complete(bar, b.x, nloc, nx); b.st[0] = nloc; b.st[1] = nx; }
        const unsigned old = xb_add(&bar[XB_XSUB(b.x)], 1u);
        const unsigned gen = old / nloc;
        if (old + 1u == (gen + 1u) * nloc) {
            __builtin_amdgcn_fence(__ATOMIC_RELEASE, "agent");
            asm volatile("s_waitcnt vmcnt(0)" ::: "memory");
            const unsigned og = xb_add(&bar[XB_TOP], 1u);
            const unsigned tg = og / nx;
            if (og + 1u == (tg + 1u) * nx) xb_add(&bar[XB_TOPGEN], 1u);
            else XB_SPIN(xb_ld(&bar[XB_TOPGEN]) == tg, bar);
            __builtin_amdgcn_fence(__ATOMIC_ACQUIRE, "agent");
            xb_add(&bar[XB_XGEN(b.x)], 1u);
            asm volatile("s_waitcnt vmcnt(0)" ::: "memory");
        } else {
            XB_SPIN(xb_ld(&bar[XB_XGEN(b.x)]) == gen, bar);
            __builtin_amdgcn_fence(__ATOMIC_ACQUIRE, "agent");
            asm volatile("s_waitcnt vmcnt(0)" ::: "memory");
        }
    }
    __syncthreads();
}

struct Args {
    const float *x, *meta, *norm_mix, *w_in, *b_fgate, *b_gate, *q_norm, *k_norm, *conv_w, *w_attn_out, *w_conv_out, *w_o, *norm_mlp, *w_up, *w_down;
    float* out; unsigned char* ws; int ph_lo, ph_hi;
};

__device__ __forceinline__ int win_src_col(int n) {
    if (n < 3072) return n;
    if (n < 5120) { const int k = (n - 3072) >> 8, w = (n - 3072) & 255; return w < 128 ? 4104 + 128 * k + w : 5128 + 128 * k + (w - 128); }
    if (n < 6144) return 3080 + (n - 5120);
    return n + 8;
}
constexpr int TR_SCR_BYTES = 64 * 65 * 4;
template <bool NT = false, bool NTL = NT>
__device__ __forceinline__ void tr_item(const float* W, int ldw, int cs, int k0, bf16* WT, int ldt, int nd, int kd, LAS float* scr, int lane, const float* kscale = nullptr) {
    const int r = lane >> 4, c4 = lane & 15;
    f32x4 v[16];
    const float* src = W + (size_t)(k0 + r) * ldw + cs + 4 * c4;
#pragma unroll
    for (int i = 0; i < 16; ++i) { if constexpr (NTL) v[i] = __builtin_nontemporal_load((const f32x4*)(src + (size_t)(4 * i) * ldw)); else v[i] = *(const f32x4*)(src + (size_t)(4 * i) * ldw); }
    if (kscale) {
#pragma unroll
        for (int i = 0; i < 16; ++i) v[i] = v[i] * kscale[k0 + 4 * i + r]; }
#pragma unroll
    for (int i = 0; i < 16; ++i) { LAS float* d = scr + (4 * i + r) * 65 + 4 * c4; d[0] = v[i][0]; d[1] = v[i][1]; d[2] = v[i][2]; d[3] = v[i][3]; }
    asm volatile("s_waitcnt lgkmcnt(0)" ::: "memory");
    const int c = lane & 7;
#pragma unroll
    for (int j = 0; j < 8; ++j) { const int n = (lane >> 3) + 8 * j; const LAS float* s = scr + (8 * c) * 65 + n;
        v4u o; o.x = pk2(s[0 * 65], s[1 * 65]); o.y = pk2(s[2 * 65], s[3 * 65]); o.z = pk2(s[4 * 65], s[5 * 65]); o.w = pk2(s[6 * 65], s[7 * 65]);
        if constexpr (NT) __builtin_nontemporal_store(o, (v4u*)(WT + (size_t)(nd + n) * ldt + kd + 8 * c)); else *(v4u*)(WT + (size_t)(nd + n) * ldt + kd + 8 * c) = o; }
    asm volatile("s_waitcnt lgkmcnt(0)" ::: "memory");
}

__device__ __forceinline__ unsigned pk4_fp8(float a, float b, float c, float d) { unsigned w = 0u; w = __builtin_amdgcn_cvt_pk_fp8_f32(a, b, w, false); w = __builtin_amdgcn_cvt_pk_fp8_f32(c, d, w, true); return w; }
__device__ __forceinline__ void tr_item_fp8(const float* W, int ldw, int cs, int k0, unsigned char* WT8, int ldt, int nd, int kd, LAS float* scr, int lane, float scale) {
    const int r = lane >> 4, c4 = lane & 15;
    f32x4 v[16];
    const float* src = W + (size_t)(k0 + r) * ldw + cs + 4 * c4;
#pragma unroll
    for (int i = 0; i < 16; ++i) v[i] = __builtin_nontemporal_load((const f32x4*)(src + (size_t)(4 * i) * ldw));
#pragma unroll
    for (int i = 0; i < 16; ++i) { LAS float* d = scr + (4 * i + r) * 65 + 4 * c4; d[0] = v[i][0] * scale; d[1] = v[i][1] * scale; d[2] = v[i][2] * scale; d[3] = v[i][3] * scale; }
    asm volatile("s_waitcnt lgkmcnt(0)" ::: "memory");
    const int c = lane & 3;
#pragma unroll
    for (int j = 0; j < 4; ++j) { const int n = (lane >> 2) + 16 * j; const LAS float* s = scr + (16 * c) * 65 + n;
        v4u o; o.x = pk4_fp8(s[0 * 65], s[1 * 65], s[2 * 65], s[3 * 65]); o.y = pk4_fp8(s[4 * 65], s[5 * 65], s[6 * 65], s[7 * 65]);
        o.z = pk4_fp8(s[8 * 65], s[9 * 65], s[10 * 65], s[11 * 65]); o.w = pk4_fp8(s[12 * 65], s[13 * 65], s[14 * 65], s[15 * 65]);
        *(v4u*)(WT8 + (size_t)(nd + n) * ldt + kd + 16 * c) = o; }
    asm volatile("s_waitcnt lgkmcnt(0)" ::: "memory");
}

__device__ __forceinline__ int meta_group_col(int g) { return g < 8 ? 1024 + 128 * g : g < 16 ? 2048 + 128 * (g - 8) : g < 24 ? 4104 + 128 * (g - 16) : 5128 + 128 * (g - 24); }
__device__ __forceinline__ void meta_partial(const Args& a, int sub, LAS unsigned char* lds, int tid) {
    const int g = sub >> 3, kc = sub & 7, col0 = meta_group_col(g), c = tid & 127, kq = tid >> 7;
    LAS float* mx = (LAS float*)lds;
    LAS float* red = (LAS float*)(lds + 16384);
    float w[64];
#pragma unroll
    for (int i = 0; i < 64; ++i) w[i] = __builtin_nontemporal_load(a.w_in + (size_t)(kc * 256 + kq * 64 + i) * INC + col0 + c);
    for (int i = tid; i < 16 * 256; i += NTHREADS) { const int r = i >> 8, d = kc * 256 + (i & 255); mx[i] = a.meta[r * DM + d] * a.norm_mix[d]; }
    __syncthreads();
    float acc[16];
#pragma unroll
    for (int r = 0; r < 16; ++r) { float s = 0.f;
#pragma unroll
        for (int i = 0; i < 64; i += 4) { const f32x4 m = *(const LAS f32x4*)(mx + r * 256 + kq * 64 + i); s += (m[0] * w[i] + m[1] * w[i + 1]) + (m[2] * w[i + 2] + m[3] * w[i + 3]); }
        acc[r] = s; }
#pragma unroll
    for (int r = 0; r < 16; ++r) red[(kq * 16 + r) * 128 + c] = acc[r];
    __syncthreads();
    float* MACC = (float*)(a.ws + WS_MACC) + ((size_t)kc * 32 + g) * 2048;
    for (int i = tid; i < 2048; i += NTHREADS) MACC[i] = (red[i] + red[2048 + i]) + (red[4096 + i] + red[6144 + i]);
    __syncthreads();
}
__device__ __forceinline__ void meta_final(const Args& a, int task, int tid) {
    const float* MACC = (const float*)(a.ws + WS_MACC); const float* rs = (const float*)(a.ws + WS_MRS);
#define MSUM(p, i) (((p)[(i)] + (p)[(i) + 65536]) + ((p)[(i) + 2 * 65536] + (p)[(i) + 3 * 65536]) + (((p)[(i) + 4 * 65536] + (p)[(i) + 5 * 65536]) + ((p)[(i) + 6 * 65536] + (p)[(i) + 7 * 65536])))
    bf16* Kb = (bf16*)(a.ws + WS_K); bf16* Vb = (bf16*)(a.ws + WS_V); bf16* UB = (bf16*)(a.ws + WS_UB);
    const int lane = tid & 63, wave = tid >> 6, kind = task >> 3, idx = task & 7;
    if (kind == 0) {
        const float* m = MACC + (size_t)idx * 2048;
        for (int r = wave * 2; r < wave * 2 + 2; ++r) { const float v0 = MSUM(m, r * 128 + lane) * rs[r], v1 = MSUM(m, r * 128 + 64 + lane) * rs[r];
            const float ss = wave_sum(v0 * v0 + v1 * v1); const float rstd = rsqrtf(ss * (1.0f / HD) + EPS);
            for (int b = 0; b < NB; ++b) { bf16* dst = Kb + ((size_t)(b * NH + idx) * LP + r) * HD;
                dst[lane] = (bf16)f2bf(v0 * rstd * a.k_norm[lane]); dst[64 + lane] = (bf16)f2bf(v1 * rstd * a.k_norm[64 + lane]); } }
    } else if (kind == 1) {
        const float* m = MACC + (size_t)(8 + idx) * 2048;
        for (int i = tid; i < 2048; i += NTHREADS) { const int r = i >> 7, c = i & 127; const unsigned short v = (unsigned short)f2bf(MSUM(m, i) * rs[r]);
            for (int b = 0; b < NB; ++b) Vb[((size_t)(b * NH + idx) * LP + r) * HD + c] = v; }
    } else {
        const float* mc = MACC + (size_t)(16 + idx) * 2048; const float* mxx = MACC + (size_t)(24 + idx) * 2048;
        for (int i = tid; i < 256; i += NTHREADS) { const int r = 14 + (i >> 7), c = i & 127; const float u = (MSUM(mc, r * 128 + c) * rs[r]) * (MSUM(mxx, r * 128 + c) * rs[r]);
            for (int b = 0; b < NB; ++b) UB[((size_t)b * UBR + (r - 14)) * CW + 128 * idx + c] = (bf16)f2bf(u); }
    }
}

__device__ __forceinline__ void norm_row(const Args& a, const float* xrow, bf16* xn_out, unsigned* xn8_out, float* lf0, float* lf1, float* rs_out, const LAS float* wf, int lane) {
    f32x4 v[8]; float s = 0.f;
#pragma unroll
    for (int j = 0; j < 8; ++j) { v[j] = __builtin_nontemporal_load((const f32x4*)xrow + lane + 64 * j); s += (v[j][0] * v[j][0] + v[j][1] * v[j][1]) + (v[j][2] * v[j][2] + v[j][3] * v[j][3]); }
    const float rstd = rsqrtf(wave_sum(s) * (1.0f / DM) + EPS);
    if (rs_out && lane == 0) *rs_out = rstd;
    float fg[8];
#pragma unroll
    for (int q = 0; q < 8; ++q) fg[q] = 0.f;
#pragma unroll
    for (int j = 0; j < 8; ++j) { const f32x4 g = *((const f32x4*)a.norm_mix + lane + 64 * j); v[j] = v[j] * rstd * g;
        if (xn_out) { *((unsigned long long*)xn_out + lane + 64 * j) = (unsigned long long)pk2(v[j][0], v[j][1]) | ((unsigned long long)pk2(v[j][2], v[j][3]) << 32);
                      xn8_out[lane + 64 * j] = pk4_fp8(v[j][0], v[j][1], v[j][2], v[j][3]); }
#pragma unroll
        for (int i = 0; i < 4; ++i) { const LAS f32x4* wp = (const LAS f32x4*)wf + ((j * 4 + i) * 2) * 64 + lane; const f32x4 w0 = wp[0], w1 = wp[64];
            fg[0] += v[j][i] * w0[0]; fg[1] += v[j][i] * w0[1]; fg[2] += v[j][i] * w0[2]; fg[3] += v[j][i] * w0[3];
            fg[4] += v[j][i] * w1[0]; fg[5] += v[j][i] * w1[1]; fg[6] += v[j][i] * w1[2]; fg[7] += v[j][i] * w1[3]; } }
#pragma unroll
    for (int q = 0; q < 8; ++q) fg[q] = wave_sum(fg[q]);
    if (lane < 8) { float z = fg[0];
#pragma unroll
        for (int q = 1; q < 8; ++q) z = (lane == q) ? fg[q] : z;
        z += a.b_fgate[lane];
        const float ls = fminf(z, 0.f) - log1pf(expf(-fabsf(z)));
        lf0[lane] = ls; if (lf1) lf1[lane] = ls; }
}

__device__ __forceinline__ void p0_prologue(const Args& a, LAS unsigned char* lds, int tid, int G) {
    const int lane = tid & 63, wave = __builtin_amdgcn_readfirstlane(tid >> 6);
    const int gw = blockIdx.x * NWAVES + wave, NGW = G * NWAVES, gt = blockIdx.x * NTHREADS + tid, NGT = G * NTHREADS;
    unsigned char* ws = a.ws;
    for (int i = gt; i < MROWS; i += NGT) ((float*)(ws + WS_SS))[i] = 0.f;
    for (int i = gt; i < NB * NH * (LP - LTOT) * HD / 8; i += NGT) { const int bh = i / ((LP - LTOT) * HD / 8), r = i % ((LP - LTOT) * HD / 8);
        const size_t off = ((size_t)bh * LP + LTOT) * HD + (size_t)r * 8; *(v4u*)((bf16*)(ws + WS_K) + off) = (v4u){0u, 0u, 0u, 0u}; *(v4u*)((bf16*)(ws + WS_V) + off) = (v4u){0u, 0u, 0u, 0u}; }
    for (int sub = blockIdx.x; sub < 256; sub += G) meta_partial(a, sub, lds, tid);
    __syncthreads();
    {
        bf16* WIN = (bf16*)(ws + WS_WIN); unsigned char* WG8 = ws + WS_WG8; LAS float* scr = (LAS float*)(lds + wave * TR_SCR_BYTES);
        constexpr int NBF = 6144, I_BF = (DM / 64) * (NBF / 64), I_G8 = (DM / 64) * ((NIN - NBF) / 64);
        for (int it = gw; it < I_BF + I_G8; it += NGW) {
            if (it < I_BF) { const int kb = it % (DM / 64), nb = it / (DM / 64); tr_item<false, true>(a.w_in, INC, win_src_col(64 * nb), 64 * kb, WIN, DM, 64 * nb, 64 * kb, scr, lane); }
            else { const int r = it - I_BF, kb = r % (DM / 64), nb = r / (DM / 64), n0 = 64 * nb, gk = n0 >> 8, gw_ = n0 & 255;
                   const int src = 6152 + (gw_ < 128 ? 128 * gk + gw_ : DM + 128 * gk + (gw_ - 128));
                   tr_item_fp8(a.w_in, INC, src, 64 * kb, WG8, DM, n0, 64 * kb, scr, lane, WG_SCALE); }
        }
    }
    __syncthreads();
    LAS float* wf = (LAS float*)lds;
    for (int i = tid; i < DM * 8; i += NTHREADS) { const int d = i >> 3, q = i & 7, ln = (d & 255) >> 2, ii = d & 3, j = d >> 8;
        wf[((((j * 4 + ii) * 2 + (q >> 2)) * 64 + ln) << 2) + (q & 3)] = a.w_in[(size_t)d * INC + 3072 + q]; }
    __syncthreads();
    float* LF = (float*)(ws + WS_LF); bf16* XN = (bf16*)(ws + WS_XN);
    for (int R = gw; R < MROWS + NMETA; R += NGW) {
        if (R < MROWS) { const int b = R / SEQ, t = R % SEQ; norm_row(a, a.x + (size_t)R * DM, XN + (size_t)R * DM, (unsigned*)(ws + WS_XN8 + (size_t)R * DM), LF + ((size_t)b * LTOT + NMETA + t) * 8, nullptr, nullptr, wf, lane); }
        else { const int r = R - MROWS; norm_row(a, a.meta + (size_t)r * DM, nullptr, nullptr, LF + (size_t)r * 8, LF + ((size_t)LTOT + r) * 8, (float*)(ws + WS_MRS) + r, wf, lane); }
    }
}

#define TR_MAP(r, nkb, nnb, kb, nb) const int kbl_ = (nkb) < 32 ? (nkb) : 32, kb = ((r) % kbl_) + kbl_ * ((r) / (kbl_ * (nnb))), nb = ((r) / kbl_) % (nnb)
__device__ __forceinline__ void tr_others(const Args& a, LAS unsigned char* lds, int it_lo, int it_hi, int wave, int lane) {
    unsigned char* ws = a.ws;
    LAS float* scr = (LAS float*)(lds + wave * TR_SCR_BYTES);
    bf16* WMIX = (bf16*)(ws + WS_WMIX); bf16* WO = (bf16*)(ws + WS_WO); bf16* WUP = (bf16*)(ws + WS_WUP); bf16* WDN = (bf16*)(ws + WS_WDN);
    constexpr int I_AO = (AW / 64) * (DM / 64), I_CO = I_AO, I_O = (DM / 64) * (DM / 64), I_UP = (DM / 64) * (DFF / 64), I_DN = (DFF / 64) * (DM / 64);
    for (int it = it_lo + wave; it < it_hi; it += NWAVES) {
        int r = it;
        if (r < I_AO) { TR_MAP(r, AW / 64, DM / 64, kb, nb); tr_item<true>(a.w_attn_out, DM, 64 * nb, 64 * kb, WMIX, 2 * AW, 64 * nb, 64 * kb, scr, lane); continue; } r -= I_AO;
        if (r < I_CO) { TR_MAP(r, AW / 64, DM / 64, kb, nb); tr_item<true>(a.w_conv_out, DM, 64 * nb, 64 * kb, WMIX, 2 * AW, 64 * nb, AW + 64 * kb, scr, lane); continue; } r -= I_CO;
        if (r < I_O) { TR_MAP(r, DM / 64, DM / 64, kb, nb); tr_item<true>(a.w_o, DM, 64 * nb, 64 * kb, WO, DM, 64 * nb, 64 * kb, scr, lane); continue; } r -= I_O;
        if (r < I_UP) { TR_MAP(r, DM / 64, DFF / 64, kb, nb); tr_item<true>(a.w_up, DFF, 64 * nb, 64 * kb, WUP, DM, 64 * nb, 64 * kb, scr, lane, a.norm_mlp); continue; } r -= I_UP;
        { TR_MAP(r, DFF / 64, DM / 64, kb, nb); tr_item<true>(a.w_down, DM, 64 * nb, 64 * kb, WDN, DFF, 64 * nb, 64 * kb, scr, lane); }
    }
}

__device__ __forceinline__ void conv_phase(const Args& a, int tid, int c_lo, int c_hi) {
    const bf16* UB = (const bf16*)(a.ws + WS_UB); const bf16* CB = (const bf16*)(a.ws + WS_CB); bf16* AC = (bf16*)(a.ws + WS_ACAT);
    for (int item = c_lo + tid; item < c_hi; item += NTHREADS) {
        const int rg = item / (CW / 8), cgp = item % (CW / 8), b = rg / (SEQ / 8), t0 = (rg % (SEQ / 8)) * 8, ch = cgp * 8;
        f32x4 w[3][2];
#pragma unroll
        for (int j = 0; j < 3; ++j) { w[j][0] = *(const f32x4*)(a.conv_w + j * CW + ch); w[j][1] = *(const f32x4*)(a.conv_w + j * CW + ch + 4); }
        v4u ur[10], cr[8];
#pragma unroll
        for (int i = 0; i < 10; ++i) ur[i] = __builtin_nontemporal_load((const v4u*)(UB + ((size_t)b * UBR + t0 + i) * CW + ch));
#pragma unroll
        for (int i = 0; i < 8; ++i) cr[i] = __builtin_nontemporal_load((const v4u*)(CB + ((size_t)b * SEQ + t0 + i) * CW + ch));
        f32x4 u0a, u0b, u1a, u1b, u2a, u2b;
        pg8::unpack8(ur[0], u0a, u0b); pg8::unpack8(ur[1], u1a, u1b);
#pragma unroll
        for (int i = 0; i < 8; ++i) {
            pg8::unpack8(ur[i + 2], u2a, u2b);
            const size_t R = (size_t)b * SEQ + t0 + i; f32x4 ca, cb2; pg8::unpack8(cr[i], ca, cb2);
            const f32x4 ya = w[0][0] * u0a + w[1][0] * u1a + w[2][0] * u2a, yb = w[0][1] * u0b + w[1][1] * u1b + w[2][1] * u2b;
            *(v4u*)(AC + R * (2 * AW) + AW + ch) = pg8::pack8(ca * ya, cb2 * yb);
            u0a = u1a; u0b = u1b; u1a = u2a; u1b = u2b;
        }
    }
}

__device__ __forceinline__ fa::BlockRef fox_ref(const Args& a, int bh, int qb) {
    fa::BlockRef r; const int b = bh >> 3, h = bh & 7;
    r.Q = (fa::gcp)(a.ws + WS_Q) + ((size_t)bh * SEQ + (size_t)qb * fa::QB) * HD;
    r.K = (fa::gcp)(a.ws + WS_K) + (size_t)bh * LP * HD; r.V = (fa::gcp)(a.ws + WS_V) + (size_t)bh * LP * HD;
    r.O = (fa::gp)(a.ws + WS_ACAT) + ((size_t)b * SEQ + (size_t)qb * fa::QB) * fa::OP + h * HD;
    r.P0 = NMETA + qb * fa::QB; r.jlo = 0;
    return r;
}
__device__ __forceinline__ void fox_bias(const Args& a, int bh, char* lds, int tid) {
    const int b = bh >> 3, h = bh & 7, lane = tid & 63, wave = tid >> 6;
    const float* LF = (const float*)(a.ws + WS_LF) + (size_t)b * LTOT * 8 + h;
    float* fb = (float*)(lds + fa::LDS_FB); float* wt = (float*)(lds + fa::LDS_SCAN);
    float v[9]; float s = 0.f;
#pragma unroll
    for (int k = 0; k < 9; ++k) { const int p = 9 * tid + k; const float x = p < LTOT ? LF[(size_t)p * 8] : 0.f; s += x; v[k] = s; }
    float inc = s;
#pragma unroll
    for (int o = 1; o < 64; o <<= 1) { const float t = __shfl_up(inc, o); if (lane >= o) inc += t; }
    if (lane == 63) wt[wave] = inc;
    __syncthreads();
    float base = inc - s;
    for (int w = 0; w < wave; ++w) base += wt[w];
#pragma unroll
    for (int k = 0; k < 9; ++k) { const int p = 9 * tid + k; if (p < LP) fb[p] = p < LTOT ? -(base + v[k]) * LOG2E : 0.f; }
    __syncthreads();
}
__device__ __forceinline__ int fox_jlo(const float* fb, int P0, float th) {
    const float lim = fb[P0] - th; const int jmax = (P0 + fa::QB - 1) / fa::KVBLK;
    int j = 0; while (j < jmax && fb[64 * j + 63] < lim) ++j;
    return __builtin_amdgcn_readfirstlane(j);
}
__device__ __forceinline__ void attn_phase(const Args& a, char* lds, int tid, int G, const int wave_u) {
    const int lane = tid & 63;
    float gq = fmaxf(fabsf(a.q_norm[lane]), fabsf(a.q_norm[64 + lane])), gk = fmaxf(fabsf(a.k_norm[lane]), fabsf(a.k_norm[64 + lane]));
#pragma unroll
    for (int o = 1; o < 64; o <<= 1) { gq = fmaxf(gq, __shfl_xor(gq, o)); gk = fmaxf(gk, __shfl_xor(gk, o)); }
    const float th = 40.f + 2.f * (128.f * QSCALE * 1.02f) * gq * gk;
    const int L = blockIdx.x;
    if (L < NB * NH * (SEQ / fa::QB)) {
        const int xcd = L & 7, k = L >> 3, bh = xcd * 2 + (k >> 4), qb = k & 15;
        fox_bias(a, bh, lds, tid);
        fa::Seam S;
        fa::BlockRef cur = fox_ref(a, bh, qb);
        cur.jlo = fox_jlo((const float*)(lds + fa::LDS_FB), cur.P0, th);
        asm volatile("" : "+s"(cur.K), "+s"(cur.V), "+s"(cur.Q), "+s"(cur.O), "+s"(cur.P0), "+s"(cur.jlo));
        fa::fox_prime(cur, lds, S, wave_u, tid & 63);
        fa::BlockRef nxt = cur;
        asm volatile("" : "+s"(nxt.K), "+s"(nxt.V), "+s"(nxt.Q), "+s"(nxt.O), "+s"(nxt.P0), "+s"(nxt.jlo));
        fa::fox_block(cur, nxt, lds, S, wave_u, tid & 63);
    }
}

__global__ void __launch_bounds__(NTHREADS, 2) fwd_kernel(Args a) {
    extern __shared__ __attribute__((aligned(16))) unsigned char lds_raw[];
    LAS unsigned char* lds = (LAS unsigned char*)lds_raw;
    const int wave_u = __builtin_amdgcn_readfirstlane((int)threadIdx.x >> 6), G = gridDim.x;
#define KTID (wave_u * 64 + lane_now())
    const int lo = a.ph_lo, hi = a.ph_hi;
    unsigned char* ws = a.ws;
#define IN(k) (lo <= (k) && (k) < hi)
    volatile LAS unsigned* MISC = (volatile LAS unsigned*)(lds + SCR_OFF + 8192);
    { const int t_ = KTID; if (t_ < 2) MISC[t_] = 0u; }
    if (hi - lo > 1) {
        if (blockIdx.x == 0) for (int i = KTID; i < XCD_BAR_WORDS; i += NTHREADS) ((unsigned*)(ws + WS_BAR))[i] = 0u;
        cg::this_grid().sync();
        (void)xcd_barrier_post((unsigned*)(ws + WS_BAR), MISC, KTID == 0);
    }
    __syncthreads();
#define SEAM(k) do { if (IN(k) && IN((k) + 1)) { { XcdBarrier bar_; bar_.bar = (unsigned*)(a.ws + WS_BAR); bar_.x = xb_xcc_id(); bar_.st = (volatile LAS unsigned*)(lds + SCR_OFF + 8192); xcd_barrier(bar_, KTID == 0); } } } while (0)
    if (IN(0)) { p0_prologue(a, lds, KTID, G); }
    SEAM(0);
    if (IN(1)) {
        for (int task = blockIdx.x; task < 24; task += G) meta_final(a, task, KTID);
        {
            pg8::Gemm g{(const bf16*)(ws + WS_XN), (const bf16*)(ws + WS_WIN), DM, DM}; pg8::StaticOrder S; S.init(MROWS, 6144, G, (int)blockIdx.x);
            pg8::EpiInProj E{(bf16*)(ws + WS_Q), (bf16*)(ws + WS_K), (bf16*)(ws + WS_V), (bf16*)(ws + WS_UB), (bf16*)(ws + WS_CB), a.q_norm, a.k_norm, (LAS float*)(lds + SCR_OFF)};
            pg8::gemm_phase<pg8::EpiInProj, pg8::StaticOrder, true, true>(lds, g, S, E, wave_u);
        }
        {
            pg8::Gemm g{(const bf16*)(ws + WS_XN8), (const bf16*)(ws + WS_WG8), DM / 2, DM / 2}; pg8::StaticOrder S; S.init(MROWS, 2 * DM, G, (int)blockIdx.x);
            pg8::EpiGate E{(bf16*)(ws + WS_G), a.b_gate};
            pg8::gemm_phase<pg8::EpiGate, pg8::StaticOrder, true, true, true>(lds, g, S, E, wave_u);
        }
    }
    SEAM(1);
    if (IN(2)) {
        constexpr int N_CONV = (MROWS / 8) * (CW / 8), N_TR = 2 * (AW / 64) * (DM / 64) + (DM / 64) * (DM / 64) + 2 * (DM / 64) * (DFF / 64);
        const int k_ = (int)blockIdx.x >> 3, x_ = (int)blockIdx.x & 7;
        auto wq = [](int qb) { return qb == 0 ? 56 : qb == 1 ? 50 : qb == 2 ? 44 : qb == 3 ? 38 : 34; };
        int cum = 0; for (int kk = 0; kk < k_; ++kk) cum += wq(kk & 15);
        constexpr int WTOT = 8 * 2 * (56 + 50 + 44 + 38 + 12 * 34);
        const long p0 = 8L * cum + (long)x_ * wq(k_ & 15), p1 = p0 + wq(k_ & 15);
        const int c_lo = (int)(p0 * N_CONV / WTOT), c_hi = (int)(p1 * N_CONV / WTOT), t_lo = (int)(p0 * N_TR / WTOT), t_hi = (int)(p1 * N_TR / WTOT);
        const bool side_first = (k_ & 1) != 0;
        if (side_first) {
            conv_phase(a, KTID, c_lo, c_hi);
            tr_others(a, lds, t_lo, t_hi, wave_u, lane_now());
            __syncthreads();
        }
        attn_phase(a, (char*)lds_raw, KTID, G, wave_u);
        if (!side_first) {
            __syncthreads();
            conv_phase(a, KTID, c_lo, c_hi);
            tr_others(a, lds, t_lo, t_hi, wave_u, lane_now());
        }
    }
    SEAM(2);
    if (IN(3)) {
        pg8::Gemm g{(const bf16*)(ws + WS_ACAT), (const bf16*)(ws + WS_WMIX), 2 * AW, 2 * AW}; pg8::StaticOrder S; S.init(MROWS, DM, G, (int)blockIdx.x);
        pg8::EpiMix E{(const bf16*)(ws + WS_G), (bf16*)(ws + WS_MG)};
        pg8::gemm_phase<pg8::EpiMix, pg8::StaticOrder, true, true>(lds, g, S, E, wave_u);
    }
    SEAM(3);
    if (IN(4)) {
        pg8::Gemm g{(const bf16*)(ws + WS_MG), (const bf16*)(ws + WS_WO), DM, DM}; pg8::StaticOrder S; S.init(MROWS, DM, G, (int)blockIdx.x);
        pg8::EpiWo E{a.x, (bf16*)(ws + WS_H1G), (float*)(ws + WS_SS)};
        pg8::gemm_phase<pg8::EpiWo, pg8::StaticOrder, true, true>(lds, g, S, E, wave_u);
    }
    SEAM(4);
    if (IN(5)) {
        pg8::Gemm g{(const bf16*)(ws + WS_H1G), (const bf16*)(ws + WS_WUP), DM, DM}; pg8::StaticOrder S; S.init(MROWS, DFF, G, (int)blockIdx.x);
        pg8::EpiUp E{(const float*)(ws + WS_SS), (bf16*)(ws + WS_UU)};
        pg8::gemm_phase<pg8::EpiUp, pg8::StaticOrder, true, true>(lds, g, S, E, wave_u);
    }
    SEAM(5);
    if (IN(6)) {
        pg8::Gemm g{(const bf16*)(ws + WS_UU), (const bf16*)(ws + WS_WDN), DFF, DFF}; pg8::StaticOrder S; S.init(MROWS, DM, G, (int)blockIdx.x);
        pg8::EpiDown E{(const bf16*)(ws + WS_H1G), a.out};
        pg8::gemm_phase<pg8::EpiDown, pg8::StaticOrder, true, true>(lds, g, S, E, wave_u);
    }
#undef IN
#undef SEAM
}

extern "C" void kernel_launch(void* const* d_in, const int* in_sizes, int n_in, void* d_out, int out_size, void* d_ws, size_t ws_size, hipStream_t stream) {
    static int grid = 0;
    if (grid == 0) {
        if (n_in != 15 || in_sizes[0] != MROWS * DM || out_size != MROWS * DM || ws_size < WS_END) {
            fprintf(stderr, "kernel_launch: unexpected shapes (n_in %d, in0 %d, out %d, ws %zu; need ws >= %zu); nothing launched\n", n_in, n_in > 0 ? in_sizes[0] : -1, out_size, ws_size, (size_t)WS_END); grid = -1; return; }
        int dev = 0, cus = 0, per_cu = 0;
        if (hipGetDevice(&dev) != hipSuccess || hipDeviceGetAttribute(&cus, hipDeviceAttributeMultiprocessorCount, dev) != hipSuccess) { grid = -1; return; }
        if (hipFuncSetAttribute((const void*)fwd_kernel, hipFuncAttributeMaxDynamicSharedMemorySize, LDS_BYTES) != hipSuccess) { fprintf(stderr, "kernel_launch: hipFuncSetAttribute failed\n"); grid = -1; return; }
        if (hipOccupancyMaxActiveBlocksPerMultiprocessor(&per_cu, (const void*)fwd_kernel, NTHREADS, LDS_BYTES) != hipSuccess || per_cu < 1) { fprintf(stderr, "kernel_launch: occupancy query says %d blocks per CU\n", per_cu); (void)hipGetLastError(); grid = -1; return; }
        grid = cus;
        if (grid != 256) { fprintf(stderr, "kernel_launch: built for a 256-CU device (one workgroup per CU), found %d\n", grid); grid = -1; return; }
    }
    if (grid < 0) return;
    Args a{};
    a.x = (const float*)d_in[0]; a.meta = (const float*)d_in[1]; a.norm_mix = (const float*)d_in[2]; a.w_in = (const float*)d_in[3]; a.b_fgate = (const float*)d_in[4];
    a.b_gate = (const float*)d_in[5]; a.q_norm = (const float*)d_in[6]; a.k_norm = (const float*)d_in[7]; a.conv_w = (const float*)d_in[8]; a.w_attn_out = (const float*)d_in[9];
    a.w_conv_out = (const float*)d_in[10]; a.w_o = (const float*)d_in[11]; a.norm_mlp = (const float*)d_in[12]; a.w_up = (const float*)d_in[13]; a.w_down = (const float*)d_in[14];
    a.out = (float*)d_out; a.ws = (unsigned char*)d_ws;
    if (N_LAUNCHES == 1) {
        a.ph_lo = 0; a.ph_hi = N_PHASES;
        void* args[] = {&a};
        hipError_t e = hipLaunchCooperativeKernel((const void*)fwd_kernel, dim3(grid), dim3(NTHREADS), args, LDS_BYTES, stream);
        if (e != hipSuccess) fprintf(stderr, "kernel_launch: cooperative launch failed: %s (grid %d)\n", hipGetErrorString(e), grid);
    } else {
        for (int p = 0; p < N_PHASES; ++p) { a.ph_lo = p; a.ph_hi = p + 1; hipLaunchKernelGGL(fwd_kernel, dim3(grid), dim3(NTHREADS), LDS_BYTES, stream, a); }
    }
}
```

```cpp
#include <hip/hip_runtime.h>
#include <hip/hip_cooperative_groups.h>
#include <hip/hip_bf16.h>
#include <cstdio>
#include <cstdint>
namespace cg = cooperative_groups;

#ifndef MK_N_LAUNCHES
#define MK_N_LAUNCHES 1
#endif

constexpr int DM = 2048, NB = 2, SEQ = 4096, NMETA = 16, LTOT = NMETA + SEQ;
constexpr int NH = 8, HD = 128, AW = 1024, CW = 1024, DFF = 8192;
constexpr int MROWS = NB * SEQ;
constexpr int INC = 10248;
constexpr int NIN = 10240;
constexpr int LP = 4160;
constexpr int UBR = SEQ + 2;
constexpr float EPS = 1e-6f;
constexpr float LOG2E = 1.4426950408889634f;
constexpr float QSCALE = 0.08838834764831845f * LOG2E;
constexpr float WG_SCALE = 64.f;

__device__ __forceinline__ int lane_now() { int l; asm volatile("v_mbcnt_lo_u32_b32 %0, -1, 0\n\tv_mbcnt_hi_u32_b32 %0, -1, %0" : "=v"(l)); return l; }
namespace pg8 {
#define PG8_LAS __attribute__((address_space(3)))
typedef unsigned short bf16_t;
typedef short bf16x8 __attribute__((ext_vector_type(8)));
typedef float f32x4 __attribute__((ext_vector_type(4)));
typedef unsigned u32x4 __attribute__((ext_vector_type(4)));
typedef int i32x4 __attribute__((ext_vector_type(4)));
typedef int i32x8 __attribute__((ext_vector_type(8)));
constexpr int BM = 256, BK = 64, HALF = 128, HTB = HALF * BK * 2, STAGE_BYTES = 8 * HTB, NXCD = 8, WGM = 4;

__host__ __device__ __forceinline__ int lds_byte(int r, int c) { const int st = (r >> 4) * 2 + (c >> 5), rr = r & 15, cc = c & 31, ob = rr * 64 + cc * 2; return st * 1024 + (ob ^ (((ob >> 9) & 1) << 5)); }
__host__ __device__ __forceinline__ void stage_rc(int b, int& R, int& C) { const int st = b / 1024, sb = b % 1024, swz = sb ^ (((sb >> 9) & 1) << 5); R = (st >> 1) * 16 + swz / 64; C = (st & 1) * 32 + (swz % 64) / 2; }
__host__ __device__ __forceinline__ int perm32(int rho) { const int n = rho >> 4, i = rho & 15; return 8 * (i >> 2) + 4 * n + (i & 3); }

struct Unit { int pm, pn, ko; };
struct Gemm { const bf16_t* A; const bf16_t* Bt; int ld, K; };

struct StaticOrder {
    int nM, nN, nwg, G, c;
    __host__ __device__ void init(int M, int N, int G_, int c_) { nM = M / BM; nN = N / BM; nwg = nM * nN; G = G_; c = c_; }
    __host__ __device__ bool next(int i, Unit& u) const {
        const long L = (long)i * G + c; if (L >= nwg) return false;
        int wgid = (int)L; { const int q = nwg / NXCD, r = nwg % NXCD, xcd = wgid % NXCD, off = wgid / NXCD; wgid = (xcd < r ? xcd * (q + 1) : r * (q + 1) + (xcd - r) * q) + off; }
        const int nig = WGM * nN, gid = wgid / nig, fm = gid * WGM, gsz = (nM - fm) < WGM ? (nM - fm) : WGM;
        u.pm = fm + ((wgid % nig) % gsz); u.pn = (wgid % nig) / gsz; u.ko = 0; return true;
    }
};
struct TwoPassOrder {
    StaticOrder S; int khalf;
    __device__ bool next(int i, Unit& u) const { if (!S.next(i >> 1, u)) return false; u.ko = (i & 1) * khalf; return true; }
};

typedef float f32x2_t __attribute__((ext_vector_type(2))); typedef __bf16 bf16x2_t __attribute__((ext_vector_type(2)));
__device__ __forceinline__ unsigned cvt_pk_bf16(float lo, float hi) { f32x2_t v = {lo, hi}; bf16x2_t b = __builtin_convertvector(v, bf16x2_t); return __builtin_bit_cast(unsigned, b); }
__device__ __forceinline__ u32x4 pack8(f32x4 a, f32x4 b) { u32x4 w; w.x = cvt_pk_bf16(a[0], a[1]); w.y = cvt_pk_bf16(a[2], a[3]); w.z = cvt_pk_bf16(b[0], b[1]); w.w = cvt_pk_bf16(b[2], b[3]); return w; }
__device__ __forceinline__ void unpack8(u32x4 w, f32x4& a, f32x4& b) {
    a[0] = __uint_as_float(w.x << 16); a[1] = __uint_as_float(w.x & 0xffff0000u); a[2] = __uint_as_float(w.y << 16); a[3] = __uint_as_float(w.y & 0xffff0000u);
    b[0] = __uint_as_float(w.z << 16); b[1] = __uint_as_float(w.z & 0xffff0000u); b[2] = __uint_as_float(w.w << 16); b[3] = __uint_as_float(w.w & 0xffff0000u);
}
__device__ __forceinline__ float dot4(f32x4 a) { return (a[0] * a[0] + a[1] * a[1]) + (a[2] * a[2] + a[3] * a[3]); }


struct EpiInProj {
    static constexpr bool PERM = true, AFTER_DRAIN = false, MIDK = false;
    bf16_t *Q, *Kb, *Vb, *UB, *CB; const float *qn, *kn; PG8_LAS float* scr;
    __device__ __forceinline__ void operator()(const f32x4 (&acc)[2][2][4][2], const Unit& u, int wr, int wc, int fr, int fq) const {
        const int pn = u.pn, pm = u.pm, b = pm >> 4, t0 = (pm & 15) * 256; int rl0 = wr * 64 + fr, c8 = wc * 32 + 8 * fq;
        asm volatile("" : "+v"(rl0), "+v"(c8));
        if (pn < 8) {
            const bool isq = pn < 4; const int hp = (isq ? pn : pn - 4) * 2; const float* gn = isq ? qn : kn;
            f32x4 g0 = *(const f32x4*)(gn + c8), g1 = *(const f32x4*)(gn + c8 + 4);
            if (isq) { g0 = g0 * QSCALE; g1 = g1 * QSCALE; }
#pragma unroll
            for (int ai = 0; ai < 2; ++ai)
#pragma unroll
                for (int m = 0; m < 4; ++m)
#pragma unroll
                    for (int bj = 0; bj < 2; ++bj) {
                        float s = dot4(acc[ai][bj][m][0]) + dot4(acc[ai][bj][m][1]);
                        s += __shfl_xor(s, 16); s += __shfl_xor(s, 32);
                        if (fq == 0) scr[((ai * 128 + rl0 + 16 * m) * 2 + bj) * 4 + wc] = s;
                    }
            asm volatile("s_waitcnt lgkmcnt(0)" ::: "memory"); __builtin_amdgcn_s_barrier(); asm volatile("" ::: "memory");
#pragma unroll
            for (int ai = 0; ai < 2; ++ai)
#pragma unroll
                for (int m = 0; m < 4; ++m) {
                    const int rl = ai * 128 + rl0 + 16 * m, t = t0 + rl;
#pragma unroll
                    for (int bj = 0; bj < 2; ++bj) {
                        const f32x4 p = *(const PG8_LAS f32x4*)(scr + (rl * 2 + bj) * 4);
                        const float rstd = rsqrtf(((p[0] + p[1]) + (p[2] + p[3])) * (1.0f / 128.0f) + EPS);
                        const f32x4 v0 = acc[ai][bj][m][0] * rstd * g0, v1 = acc[ai][bj][m][1] * rstd * g1;
                        const int bh = b * NH + hp + bj;
                        bf16_t* dst = isq ? Q + ((size_t)bh * SEQ + t) * HD + c8 : Kb + ((size_t)bh * LP + NMETA + t) * HD + c8;
                        *(u32x4*)dst = pack8(v0, v1);
                    }
                }
        } else if (pn < 12) {
#pragma unroll
            for (int ai = 0; ai < 2; ++ai)
#pragma unroll
                for (int m = 0; m < 4; ++m) { const int t = t0 + ai * 128 + rl0 + 16 * m;
#pragma unroll
                    for (int bj = 0; bj < 2; ++bj) { const int bh = b * NH + (pn - 8) * 2 + bj;
                        *(u32x4*)(Vb + ((size_t)bh * LP + NMETA + t) * HD + c8) = pack8(acc[ai][bj][m][0], acc[ai][bj][m][1]); } }
        } else if (pn < 20) {
            const int ch = (pn - 12) * 128 + c8;
#pragma unroll
            for (int ai = 0; ai < 2; ++ai)
#pragma unroll
                for (int m = 0; m < 4; ++m) { const int t = t0 + ai * 128 + rl0 + 16 * m;
                    *(u32x4*)(UB + ((size_t)b * UBR + 2 + t) * CW + ch) = pack8(acc[ai][0][m][0] * acc[ai][1][m][0], acc[ai][0][m][1] * acc[ai][1][m][1]); }
        } else {
#pragma unroll
            for (int ai = 0; ai < 2; ++ai)
#pragma unroll
                for (int m = 0; m < 4; ++m) { const size_t R = (size_t)pm * 256 + ai * 128 + rl0 + 16 * m;
#pragma unroll
                    for (int bj = 0; bj < 2; ++bj) *(u32x4*)(CB + R * CW + (pn - 20) * 256 + bj * 128 + c8) = pack8(acc[ai][bj][m][0], acc[ai][bj][m][1]); }
        }
    }
};
struct EpiGate {
    static constexpr bool PERM = true, AFTER_DRAIN = false, MIDK = false;
    bf16_t* G; const float* bg;
    __device__ __forceinline__ void operator()(const f32x4 (&acc)[2][2][4][2], const Unit& u, int wr, int wc, int fr, int fq) const {
        int rl0 = wr * 64 + fr, c8 = wc * 32 + 8 * fq; asm volatile("" : "+v"(rl0), "+v"(c8));
        const int ch = u.pn * 128 + c8;
        f32x4 bv[2][2];
#pragma unroll
        for (int bj = 0; bj < 2; ++bj) { bv[bj][0] = *(const f32x4*)(bg + bj * DM + ch); bv[bj][1] = *(const f32x4*)(bg + bj * DM + ch + 4); }
#pragma unroll
        for (int ai = 0; ai < 2; ++ai)
#pragma unroll
            for (int m = 0; m < 4; ++m) { const size_t R = (size_t)u.pm * 256 + ai * 128 + rl0 + 16 * m;
                f32x4 rt[2], g1[2];
#pragma unroll
                for (int n = 0; n < 2; ++n) { const f32x4 z0 = acc[ai][0][m][n] * (1.0f / WG_SCALE) + bv[0][n], z1 = acc[ai][1][m][n] * (1.0f / WG_SCALE) + bv[1][n];
#pragma unroll
                    for (int j = 0; j < 4; ++j) { const float e0 = 1.0f + __builtin_amdgcn_exp2f(-z0[j] * LOG2E), e1 = 1.0f + __builtin_amdgcn_exp2f(-z1[j] * LOG2E);
                        g1[n][j] = __builtin_amdgcn_rcpf(e1); rt[n][j] = e1 * __builtin_amdgcn_rcpf(e0); } }
                *(u32x4*)(G + R * (2 * DM) + ch) = pack8(rt[0], rt[1]); *(u32x4*)(G + R * (2 * DM) + DM + ch) = pack8(g1[0], g1[1]); }
    }
};
struct EpiMix {
    static constexpr bool PERM = true, AFTER_DRAIN = false, MIDK = true;
    const bf16_t* G; bf16_t* MG;
    __device__ __forceinline__ void mid(f32x4 (&acc)[2][2][4][2], const Unit& u, int wr, int wc, int fr, int fq) const {
        int cl = wc * 32 + 8 * fq, rl = wr * 64 + fr; asm volatile("" : "+v"(cl), "+v"(rl)); const int col0 = u.pn * 256 + cl;
#pragma unroll
        for (int ai = 0; ai < 2; ++ai)
#pragma unroll
            for (int mh = 0; mh < 2; ++mh) { u32x4 g0[2][2];
#pragma unroll
                for (int mm = 0; mm < 2; ++mm) { const size_t R = (size_t)u.pm * 256 + ai * 128 + 16 * (2 * mh + mm) + rl;
#pragma unroll
                    for (int bj = 0; bj < 2; ++bj) g0[mm][bj] = *(const u32x4*)(G + R * (2 * DM) + col0 + bj * 128); }
#pragma unroll
                for (int mm = 0; mm < 2; ++mm)
#pragma unroll
                    for (int bj = 0; bj < 2; ++bj) { const int m = 2 * mh + mm; f32x4 ga, gb; unpack8(g0[mm][bj], ga, gb);
                        acc[ai][bj][m][0] = acc[ai][bj][m][0] * ga; acc[ai][bj][m][1] = acc[ai][bj][m][1] * gb; } }
    }
    __device__ __forceinline__ void operator()(const f32x4 (&acc)[2][2][4][2], const Unit& u, int wr, int wc, int fr, int fq) const {
        int cl = wc * 32 + 8 * fq, rl = wr * 64 + fr; asm volatile("" : "+v"(cl), "+v"(rl)); const int col0 = u.pn * 256 + cl;
#pragma unroll
        for (int ai = 0; ai < 2; ++ai) { u32x4 g1[4][2];
#pragma unroll
            for (int m = 0; m < 4; ++m) { const size_t R = (size_t)u.pm * 256 + ai * 128 + 16 * m + rl;
#pragma unroll
                for (int bj = 0; bj < 2; ++bj) g1[m][bj] = *(const u32x4*)(G + R * (2 * DM) + DM + col0 + bj * 128); }
#pragma unroll
            for (int m = 0; m < 4; ++m) { const size_t R = (size_t)u.pm * 256 + ai * 128 + 16 * m + rl;
#pragma unroll
                for (int bj = 0; bj < 2; ++bj) { f32x4 ha, hb; unpack8(g1[m][bj], ha, hb);
                    *(u32x4*)(MG + R * DM + col0 + bj * 128) = pack8(ha * acc[ai][bj][m][0], hb * acc[ai][bj][m][1]); } } }
    }
};
struct EpiWo {
    static constexpr bool PERM = true, AFTER_DRAIN = false, MIDK = false;
    const float* x; bf16_t* H1; float* SS;
    __device__ __forceinline__ void operator()(const f32x4 (&acc)[2][2][4][2], const Unit& u, int wr, int wc, int fr, int fq) const {
        int cl = wc * 32 + 8 * fq, rl = wr * 64 + fr; asm volatile("" : "+v"(cl), "+v"(rl)); const int col0 = u.pn * 256 + cl;
#pragma unroll
        for (int ai = 0; ai < 2; ++ai)
#pragma unroll
            for (int mh = 0; mh < 2; ++mh) { f32x4 xv[2][2][2];
#pragma unroll
                for (int mm = 0; mm < 2; ++mm) { const size_t R = (size_t)u.pm * 256 + ai * 128 + 16 * (2 * mh + mm) + rl;
#pragma unroll
                    for (int bj = 0; bj < 2; ++bj) { const float* xp = x + R * DM + col0 + bj * 128; xv[mm][bj][0] = __builtin_nontemporal_load((const f32x4*)xp); xv[mm][bj][1] = __builtin_nontemporal_load((const f32x4*)(xp + 4)); } }
#pragma unroll
                for (int mm = 0; mm < 2; ++mm) { const int m = 2 * mh + mm; const size_t R = (size_t)u.pm * 256 + ai * 128 + 16 * m + rl; float s = 0.f;
#pragma unroll
                    for (int bj = 0; bj < 2; ++bj) { const f32x4 h0 = xv[mm][bj][0] + acc[ai][bj][m][0], h1 = xv[mm][bj][1] + acc[ai][bj][m][1];
                        *(u32x4*)(H1 + R * DM + col0 + bj * 128) = pack8(h0, h1);
                        s += dot4(h0) + dot4(h1); }
                    s += __shfl_xor(s, 16); s += __shfl_xor(s, 32);
                    if (fq == 0) atomicAdd(SS + R, s); } }
    }
};
struct EpiUp {
    static constexpr bool PERM = true, AFTER_DRAIN = false, MIDK = false;
    const float* SS; bf16_t* U;
    __device__ __forceinline__ void operator()(const f32x4 (&acc)[2][2][4][2], const Unit& u, int wr, int wc, int fr, int fq) const {
        int cl = wc * 32 + 8 * fq, rl = wr * 64 + fr; asm volatile("" : "+v"(cl), "+v"(rl)); const int col0 = u.pn * 256 + cl;
        float ssv[2][4];
#pragma unroll
        for (int ai = 0; ai < 2; ++ai)
#pragma unroll
            for (int m = 0; m < 4; ++m) ssv[ai][m] = SS[(size_t)u.pm * 256 + ai * 128 + 16 * m + rl];
#pragma unroll
        for (int ai = 0; ai < 2; ++ai)
#pragma unroll
            for (int m = 0; m < 4; ++m) { const size_t R = (size_t)u.pm * 256 + ai * 128 + 16 * m + rl;
                const float rstd = rsqrtf(ssv[ai][m] * (1.0f / DM) + EPS);
#pragma unroll
                for (int bj = 0; bj < 2; ++bj) { f32x4 v[2];
#pragma unroll
                    for (int n = 0; n < 2; ++n)
#pragma unroll
                        for (int j = 0; j < 4; ++j) { const float r = fmaxf(acc[ai][bj][m][n][j] * rstd, 0.f); v[n][j] = r * r; }
                    *(u32x4*)(U + R * DFF + col0 + bj * 128) = pack8(v[0], v[1]); } }
    }
};
struct EpiDown {
    static constexpr bool PERM = true, AFTER_DRAIN = false, MIDK = false;
    const bf16_t* H1; float* out;
    __device__ __forceinline__ void operator()(const f32x4 (&acc)[2][2][4][2], const Unit& u, int wr, int wc, int fr, int fq) const {
        int cl = wc * 32 + 8 * fq, rl = wr * 64 + fr; asm volatile("" : "+v"(cl), "+v"(rl)); const int col0 = u.pn * 256 + cl;
#pragma unroll
        for (int ai = 0; ai < 2; ++ai) { u32x4 hv[4][2];
#pragma unroll
            for (int m = 0; m < 4; ++m) { const size_t R = (size_t)u.pm * 256 + ai * 128 + 16 * m + rl;
#pragma unroll
                for (int bj = 0; bj < 2; ++bj) hv[m][bj] = *(const u32x4*)(H1 + R * DM + col0 + bj * 128); }
#pragma unroll
            for (int m = 0; m < 4; ++m) { const size_t R = (size_t)u.pm * 256 + ai * 128 + 16 * m + rl;
#pragma unroll
                for (int bj = 0; bj < 2; ++bj) { const size_t off = R * DM + col0 + bj * 128;
                    f32x4 ha, hb; unpack8(hv[m][bj], ha, hb);
                    *(f32x4*)(out + off) = ha + acc[ai][bj][m][0]; *(f32x4*)(out + off + 4) = hb + acc[ai][bj][m][1]; } } }
    }
};

template <class Epi, class Sched, bool ALIGN_EPI = false, bool SP2 = false, bool FP8 = false>
__device__ __forceinline__ void gemm_phase(PG8_LAS unsigned char* lds, const Gemm g, const Sched& S, const Epi& E, const int wave_u) {
    const int wid = wave_u, lane = lane_now(), tid = wid * 64 + lane, wr = wid >> 2, wc = wid & 3, fr = lane & 15, fq = lane >> 4;
    const int K = g.K, nt = K / BK, ld = g.ld;
    unsigned voffA[2], voffB[2];
#pragma unroll
    for (int i = 0; i < 2; ++i) { int R, C; stage_rc(tid * 16 + i * 8192, R, C); const int Rb = Epi::PERM ? ((R & ~31) + perm32(R & 31)) : R;
        voffA[i] = (unsigned)(R * ld + C) * 2u; voffB[i] = (unsigned)(Rb * ld + C) * 2u; }
    const size_t kstep = (size_t)(BK * 2);
    const size_t hstep = (size_t)HALF * ld * 2;
    const size_t tstep = 2 * hstep;
    const unsigned ldsw = (unsigned)wid * 1024u;
    const int aoff = lds_byte(wr * 64 + fr, fq * 8), boff = lds_byte(wc * 32 + fr, fq * 8);
#define PG8_SA(b, h) (((b) * 2 + (h)) * HTB)
#define PG8_SB(b, h) ((4 + (b) * 2 + (h)) * HTB)
#define PG8_STAGE(bufoff, gbase, voff) do { const char* gb_ = (const char*)(gbase); asm volatile("" : "+s"(gb_));     \
        _Pragma("unroll") for (int _i = 0; _i < 2; ++_i) { unsigned vo_ = (voff)[_i]; asm volatile("" : "+v"(vo_)); \
        __builtin_amdgcn_global_load_lds((const unsigned*)(gb_ + vo_), (PG8_LAS unsigned*)(lds + (bufoff) + ldsw + _i * 8192), 16, 0, 0); } } while (0)
#define PG8_F8(lo, hi) __builtin_shufflevector(__builtin_bit_cast(i32x4, lo), __builtin_bit_cast(i32x4, hi), 0, 1, 2, 3, 4, 5, 6, 7)
#define PG8_LDA(dst, b, h) do { _Pragma("unroll") for (int m = 0; m < 4; ++m) { const PG8_LAS bf16x8* p_ = (const PG8_LAS bf16x8*)(lds + PG8_SA(b, h) + aoff + m * 2048); \
        if constexpr (FP8) dst##8[m] = PG8_F8(p_[0], p_[64]); else { dst[m][0] = p_[0]; dst[m][1] = p_[64]; } } } while (0)
#define PG8_LDB(dst, b, h) do { _Pragma("unroll") for (int n = 0; n < 2; ++n) { const PG8_LAS bf16x8* p_ = (const PG8_LAS bf16x8*)(lds + PG8_SB(b, h) + boff + n * 2048); \
        if constexpr (FP8) dst##8[n] = PG8_F8(p_[0], p_[64]); else { dst[n][0] = p_[0]; dst[n][1] = p_[64]; } } } while (0)
#define PG8_MMA(ai, bj, At, Bt) do { __builtin_amdgcn_s_setprio(1); \
        if constexpr (FP8) { _Pragma("unroll") for (int m = 0; m < 4; ++m) _Pragma("unroll") for (int n = 0; n < 2; ++n) \
            acc[ai][bj][m][n] = __builtin_amdgcn_mfma_scale_f32_16x16x128_f8f6f4(Bt##8[n], At##8[m], acc[ai][bj][m][n], 0, 0, 0, 0x7f7f7f7f, 0, 0x7f7f7f7f); } \
        else { _Pragma("unroll") for (int k = 0; k < 2; ++k) _Pragma("unroll") for (int m = 0; m < 4; ++m) _Pragma("unroll") for (int n = 0; n < 2; ++n)     \
            acc[ai][bj][m][n] = __builtin_amdgcn_mfma_f32_16x16x32_bf16(Bt[n][k], At[m][k], acc[ai][bj][m][n], 0, 0, 0); } \
        __builtin_amdgcn_s_setprio(0); } while (0)
#define PG8_WAIT_V(n) asm volatile("s_waitcnt vmcnt(" #n ")" ::: "memory")
#define PG8_WAIT_L(n) asm volatile("s_waitcnt lgkmcnt(" #n ")" ::: "memory")
#define PG8_BAR __builtin_amdgcn_s_barrier()
#define PG8_SCHED __builtin_amdgcn_sched_barrier(0)
    Unit cur, nxt; int ui = 0;
    if (!S.next(0, cur)) return;
    f32x4 acc[2][2][4][2];
#pragma unroll
    for (int a = 0; a < 2; ++a)
#pragma unroll
        for (int b = 0; b < 2; ++b)
#pragma unroll
            for (int m = 0; m < 4; ++m)
#pragma unroll
                for (int n = 0; n < 2; ++n) acc[a][b][m][n] = (f32x4){0.f, 0.f, 0.f, 0.f};
    bf16x8 At[4][2], B0[2][2], B1[2][2];
    i32x8 At8[4], B08[2], B18[2];
    const char* cA = (const char*)g.A + (size_t)cur.pm * tstep + (size_t)cur.ko * 2; const char* cB = (const char*)g.Bt + (size_t)cur.pn * tstep + (size_t)cur.ko * 2;
    if constexpr (SP2) {
        PG8_STAGE(PG8_SB(0, 0), cB, voffB); PG8_STAGE(PG8_SB(0, 1), cB + hstep, voffB); PG8_STAGE(PG8_SA(0, 0), cA, voffA); PG8_STAGE(PG8_SA(0, 1), cA + hstep, voffA);
        if (wr == 1) PG8_BAR;
        PG8_WAIT_V(2); PG8_BAR;
        PG8_STAGE(PG8_SB(1, 0), cB + kstep, voffB); PG8_STAGE(PG8_SA(1, 0), cA + kstep, voffA); PG8_STAGE(PG8_SB(1, 1), cB + hstep + kstep, voffB);
        PG8_WAIT_V(6); PG8_BAR;
    } else {
        PG8_STAGE(PG8_SB(0, 0), cB, voffB); PG8_STAGE(PG8_SA(0, 0), cA, voffA); PG8_STAGE(PG8_SB(0, 1), cB + hstep, voffB); PG8_STAGE(PG8_SA(0, 1), cA + hstep, voffA);
        if (wr == 1) PG8_BAR;
        PG8_WAIT_V(4); PG8_BAR;
        PG8_STAGE(PG8_SB(1, 0), cB + kstep, voffB); PG8_STAGE(PG8_SA(1, 0), cA + kstep, voffA); PG8_STAGE(PG8_SB(1, 1), cB + hstep + kstep, voffB);
        PG8_WAIT_V(6); PG8_BAR;
    }
    for (;;) {
        const bool has_next = S.next(ui + 1, nxt);
        const char* nA = has_next ? (const char*)g.A + (size_t)nxt.pm * tstep + (size_t)nxt.ko * 2 : cA; const char* nB = has_next ? (const char*)g.Bt + (size_t)nxt.pn * tstep + (size_t)nxt.ko * 2 : cB;
        for (int t = 0; t < nt; t += 2) {
            const bool last = (t == nt - 2);
            const char* a1 = cA + (size_t)(t + 1) * kstep;
            const char* a2 = last ? nA : cA + (size_t)(t + 2) * kstep; const char* b2 = last ? nB : cB + (size_t)(t + 2) * kstep;
            const char* a3 = a2 + kstep; const char* b3 = b2 + kstep;
            if constexpr (Epi::MIDK) { if (t == (nt >> 1)) E.mid(acc, cur, wr, wc, fr, fq); }
            if constexpr (SP2) {
            PG8_LDB(B0, 0, 0); PG8_LDB(B1, 0, 1); PG8_SCHED; PG8_LDA(At, 0, 0); PG8_STAGE(PG8_SA(1, 1), a1 + hstep, voffA);
            PG8_WAIT_V(8); PG8_WAIT_L(0); PG8_BAR; PG8_MMA(0, 0, At, B0); PG8_MMA(0, 1, At, B1); PG8_BAR; PG8_SCHED;
            PG8_LDA(At, 0, 1); PG8_STAGE(PG8_SB(0, 0), b2, voffB); PG8_STAGE(PG8_SB(0, 1), b2 + hstep, voffB); PG8_STAGE(PG8_SA(0, 0), a2, voffA);
            PG8_WAIT_V(8); PG8_WAIT_L(0); PG8_BAR; PG8_MMA(1, 0, At, B0); PG8_MMA(1, 1, At, B1); PG8_BAR; PG8_SCHED;
            PG8_LDB(B0, 1, 0); PG8_LDB(B1, 1, 1); PG8_SCHED; PG8_LDA(At, 1, 0); PG8_STAGE(PG8_SA(0, 1), a2 + hstep, voffA);
            PG8_WAIT_V(8); PG8_WAIT_L(0); PG8_BAR; PG8_MMA(0, 0, At, B0); PG8_MMA(0, 1, At, B1); PG8_BAR; PG8_SCHED;
            PG8_LDA(At, 1, 1); PG8_STAGE(PG8_SB(1, 0), b3, voffB); PG8_STAGE(PG8_SB(1, 1), b3 + hstep, voffB); PG8_STAGE(PG8_SA(1, 0), a3, voffA);
            PG8_WAIT_V(8); PG8_WAIT_L(0); PG8_BAR; PG8_MMA(1, 0, At, B0); PG8_MMA(1, 1, At, B1); PG8_BAR; PG8_SCHED;
            } else {
            PG8_LDB(B0, 0, 0); PG8_SCHED; PG8_LDA(At, 0, 0); PG8_STAGE(PG8_SA(1, 1), a1 + hstep, voffA);
            PG8_WAIT_L(8); PG8_BAR; PG8_WAIT_L(0); PG8_MMA(0, 0, At, B0); PG8_BAR; PG8_SCHED;
            PG8_LDB(B1, 0, 1); PG8_STAGE(PG8_SB(0, 0), b2, voffB);
            PG8_BAR; PG8_WAIT_L(0); PG8_MMA(0, 1, At, B1); PG8_BAR;
            PG8_LDA(At, 0, 1); PG8_STAGE(PG8_SA(0, 0), a2, voffA);
            PG8_BAR; PG8_WAIT_L(0); PG8_MMA(1, 0, At, B0); PG8_BAR; PG8_SCHED;
            PG8_STAGE(PG8_SB(0, 1), b2 + hstep, voffB);
            PG8_WAIT_V(6); PG8_BAR; PG8_MMA(1, 1, At, B1); PG8_BAR;
            PG8_LDB(B0, 1, 0); PG8_SCHED; PG8_LDA(At, 1, 0); PG8_STAGE(PG8_SA(0, 1), a2 + hstep, voffA);
            PG8_WAIT_L(8); PG8_BAR; PG8_WAIT_L(0); PG8_MMA(0, 0, At, B0); PG8_BAR; PG8_SCHED;
            PG8_LDB(B1, 1, 1); PG8_STAGE(PG8_SB(1, 0), b3, voffB);
            PG8_BAR; PG8_WAIT_L(0); PG8_MMA(0, 1, At, B1); PG8_BAR;
            PG8_LDA(At, 1, 1); PG8_STAGE(PG8_SA(1, 0), a3, voffA);
            PG8_BAR; PG8_WAIT_L(0); PG8_MMA(1, 0, At, B0); PG8_BAR; PG8_SCHED;
            PG8_STAGE(PG8_SB(1, 1), b3 + hstep, voffB);
            PG8_WAIT_V(6); PG8_BAR; PG8_MMA(1, 1, At, B1); PG8_BAR;
            }
        }
        if constexpr (ALIGN_EPI) { if (wr == 0) PG8_BAR; }
        { const int l2 = lane_now(); E(acc, cur, wid >> 2, wid & 3, l2 & 15, l2 >> 4); }
        if (!has_next) break;
#pragma unroll
        for (int a = 0; a < 2; ++a)
#pragma unroll
            for (int b = 0; b < 2; ++b)
#pragma unroll
                for (int m = 0; m < 4; ++m)
#pragma unroll
                    for (int n = 0; n < 2; ++n) acc[a][b][m][n] = (f32x4){0.f, 0.f, 0.f, 0.f};
        cur = nxt; cA = nA; cB = nB; ++ui;
        if constexpr (ALIGN_EPI) { if (wr == 1) PG8_BAR; }
    }
    PG8_WAIT_V(0);
    if constexpr (!ALIGN_EPI) { if (wr == 0) PG8_BAR; }
    PG8_BAR;
#undef PG8_SA
#undef PG8_SB
#undef PG8_STAGE
#undef PG8_LDA
#undef PG8_LDB
#undef PG8_MMA
#undef PG8_F8
#undef PG8_WAIT_V
#undef PG8_WAIT_L
#undef PG8_BAR
#undef PG8_SCHED
}
}

namespace fa {
using bf16 = __hip_bfloat16;
typedef short bf16x8 __attribute__((ext_vector_type(8)));
typedef short s16x4 __attribute__((ext_vector_type(4)));
typedef float f32x16 __attribute__((ext_vector_type(16)));
typedef float f32x4 __attribute__((ext_vector_type(4)));
typedef unsigned u32x4 __attribute__((ext_vector_type(4)));
constexpr int D = 128, NW = 8, QBLK = 32, KVBLK = 64, QB = NW * QBLK;
constexpr int SHM_V = KVBLK * D * 2, SHM_K = KVBLK * D * 2;
constexpr int LDS_WS = 2 * SHM_V + 2 * SHM_K;
constexpr int LDS_FB = LDS_WS + NW * 64 * 4;
constexpr int LDS_SCAN = LDS_FB + LP * 4;
constexpr int LDS_BYTES = LDS_SCAN + 64;
constexpr int OP = 2 * AW;
constexpr float THR = 16.f;
constexpr unsigned WBIG = 1u << 24;

#define KSWZ(row, colB) ((row) * 256 + ((colB) ^ (((row) & 7) << 4)))
#define SBAR() __builtin_amdgcn_sched_barrier(0)
__device__ __forceinline__ int v_st(int k, int c) { const int kk = (k & ~0xC) | ((k & 4) << 1) | ((k & 8) >> 1); return ((kk >> 3) * 4 + (c >> 5)) * 512 + ((kk & 7) * 32 + (c & 31)) * 2; }
__device__ __forceinline__ int v_rd_base(int lane) { return ((lane & 3) << 3) | (((lane >> 2) & 3) << 6) | (((lane >> 4) & 1) << 5) | (((lane >> 5) & 1) << 8); }
constexpr int v_rd_off(int d0, int ks, int half) { return d0 * 512 + ks * 4096 + half * 2048; }
__device__ __forceinline__ int crow(int r, int hi) { return (r & 3) + 8 * (r >> 2) + 4 * hi; }
__device__ __forceinline__ unsigned cvtpk(float lo, float hi) { return pg8::cvt_pk_bf16(lo, hi); }
#define FA_GAS __attribute__((address_space(1)))
#define FA_LAS __attribute__((address_space(3)))
typedef const FA_GAS bf16* gcp;
typedef FA_GAS bf16* gp;
__device__ __forceinline__ bf16x8 load8(gcp p) { return *(const FA_GAS bf16x8*)p; }
__device__ __forceinline__ void mask_tile(f32x16& p0, f32x16& p1, int dq, unsigned W) {
    const float NEG = -__builtin_inff();
#pragma unroll
    for (int r = 0; r < 16; ++r) {
        const int c = (r & 3) + 8 * (r >> 2);
        if ((unsigned)(dq - c) >= W) p0[r] = NEG;
        if ((unsigned)(dq - c - 32) >= W) p1[r] = NEG;
    }
}
__device__ __forceinline__ void partialSM(f32x16& p0, f32x16& p1, float& m_reg, float& mn, float& alpha) {
    float pmax = p0[0]; for (int r = 1; r < 16; ++r) pmax = fmaxf(pmax, p0[r]); for (int r = 0; r < 16; ++r) pmax = fmaxf(pmax, p1[r]);
    { auto rr = __builtin_amdgcn_permlane32_swap(__float_as_uint(pmax), __float_as_uint(pmax), false, false);
      pmax = fmaxf(__uint_as_float(rr[0]), __uint_as_float(rr[1])); }
    if (__builtin_expect(__all((pmax - m_reg) <= THR), 1)) { mn = m_reg; alpha = 1.f; }
    else { mn = fmaxf(m_reg, pmax); alpha = __builtin_amdgcn_exp2f(m_reg - mn); m_reg = mn; }
    for (int r = 0; r < 16; ++r) p0[r] = p0[r] - mn; for (int r = 0; r < 16; ++r) p1[r] = p1[r] - mn;
    for (int r = 0; r < 16; ++r) p0[r] = __builtin_amdgcn_exp2f(p0[r]);
}
__device__ __forceinline__ void finishSM(f32x16& p0, f32x16& p1, float alpha, float& l_reg, bf16x8& pa0, bf16x8& pa1, bf16x8& pa2, bf16x8& pa3) {
    for (int r = 0; r < 16; ++r) p1[r] = __builtin_amdgcn_exp2f(p1[r]);
    float ps = 0; for (int r = 0; r < 16; ++r) ps += p0[r]; for (int r = 0; r < 16; ++r) ps += p1[r];
    { auto rr = __builtin_amdgcn_permlane32_swap(__float_as_uint(ps), __float_as_uint(ps), false, false);
      ps = __uint_as_float(rr[0]) + __uint_as_float(rr[1]); }
    l_reg = l_reg * alpha + ps;
#define PK4(P, B_, OUT) do { unsigned a0 = cvtpk(P[B_+0], P[B_+1]), a1 = cvtpk(P[B_+2], P[B_+3]);                          \
        unsigned b0 = cvtpk(P[B_+4], P[B_+5]), b1 = cvtpk(P[B_+6], P[B_+7]);                                             \
        auto r0 = __builtin_amdgcn_permlane32_swap(a0, b0, false, false); auto r1 = __builtin_amdgcn_permlane32_swap(a1, b1, false, false); \
        u32x4 w = {r0[0], r1[0], r0[1], r1[1]}; OUT = *reinterpret_cast<bf16x8*>(&w); } while (0)
    PK4(p0, 0, pa0); PK4(p0, 8, pa1); PK4(p1, 0, pa2); PK4(p1, 8, pa3);
#undef PK4
}
template <int KB>
__device__ __forceinline__ void qkt(f32x16& p0, f32x16& p1, const char* K_lds, const FA_LAS float* fb, int r32, int hi, const bf16x8* qr) {
#pragma unroll
    for (int g = 0; g < 4; ++g) { const f32x4 a = *(const FA_LAS f32x4*)(fb + 8 * g), b = *(const FA_LAS f32x4*)(fb + 32 + 8 * g);
        p0[4 * g] = a[0]; p0[4 * g + 1] = a[1]; p0[4 * g + 2] = a[2]; p0[4 * g + 3] = a[3];
        p1[4 * g] = b[0]; p1[4 * g + 1] = b[1]; p1[4 * g + 2] = b[2]; p1[4 * g + 3] = b[3]; }
    const char* kb[4];
#pragma unroll
    for (int dd = 0; dd < 4; ++dd) kb[dd] = K_lds + KB * SHM_K + KSWZ(r32, (dd * 16 + hi * 8) * 2);
#pragma unroll
    for (int d0 = 0; d0 < 8; ++d0) { const char* a = kb[d0 & 3] + (d0 >> 2) * 128;
        bf16x8 b0 = *reinterpret_cast<const bf16x8*>(a);
        bf16x8 b1 = *reinterpret_cast<const bf16x8*>(a + 32 * 256);
        p0 = __builtin_amdgcn_mfma_f32_32x32x16_bf16(b0, qr[d0], p0, 0, 0, 0);
        p1 = __builtin_amdgcn_mfma_f32_32x32x16_bf16(b1, qr[d0], p1, 0, 0, 0); }
}
template <int VB>
__device__ __forceinline__ void pv_tile(f32x16* o, int vb0, bf16x8 pa0, bf16x8 pa1, bf16x8 pa2, bf16x8 pa3) {
#define TRRD(dst, off) asm volatile("ds_read_b64_tr_b16 %0, %1 offset:%2" : "=&v"(dst) : "v"(vb0), "i"(off) : "memory")
#define PV_D0(d0) do { s16x4 l0, l1, l2, l3, h0, h1, h2, h3; constexpr int b_ = VB * SHM_V + v_rd_off(d0, 0, 0); \
        TRRD(l0, b_); TRRD(h0, b_ + 2048); TRRD(l1, b_ + 4096); TRRD(h1, b_ + 6144); TRRD(l2, b_ + 8192); TRRD(h2, b_ + 10240); TRRD(l3, b_ + 12288); TRRD(h3, b_ + 14336); \
        asm volatile("s_waitcnt lgkmcnt(0)" ::: "memory"); SBAR();   \
        o[d0] = __builtin_amdgcn_mfma_f32_32x32x16_bf16(pa0, (bf16x8){l0[0], l0[1], l0[2], l0[3], h0[0], h0[1], h0[2], h0[3]}, o[d0], 0, 0, 0);   \
        o[d0] = __builtin_amdgcn_mfma_f32_32x32x16_bf16(pa1, (bf16x8){l1[0], l1[1], l1[2], l1[3], h1[0], h1[1], h1[2], h1[3]}, o[d0], 0, 0, 0);   \
        o[d0] = __builtin_amdgcn_mfma_f32_32x32x16_bf16(pa2, (bf16x8){l2[0], l2[1], l2[2], l2[3], h2[0], h2[1], h2[2], h2[3]}, o[d0], 0, 0, 0);   \
        o[d0] = __builtin_amdgcn_mfma_f32_32x32x16_bf16(pa3, (bf16x8){l3[0], l3[1], l3[2], l3[3], h3[0], h3[1], h3[2], h3[3]}, o[d0], 0, 0, 0); } while (0)
    PV_D0(0); PV_D0(1); PV_D0(2); PV_D0(3);
#undef PV_D0
#undef TRRD
}

struct BlockRef { gcp Q; gcp K; gcp V; gp O; int P0; int jlo; };
struct Seam { bf16x8 qr[8]; bf16x8 st_v0, st_v1, st_k0, st_k1; };
#define ROW(p, k0, rr) ((p) + (size_t)((k0) + (rr)) * D + sc)
#define VMW() asm volatile("s_waitcnt vmcnt(0)" ::: "memory")
#define VMWN(n) asm volatile("s_waitcnt vmcnt(%0)" :: "i"(n) : "memory")
#define SLOAD_H(Kp, Vp, k0) do { S.st_v0 = load8(ROW(Vp, k0, sr)); S.st_v1 = load8(ROW(Vp, k0, 32 + sr));              \
                         S.st_k0 = load8(ROW(Kp, k0, sr)); S.st_k1 = load8(ROW(Kp, k0, 32 + sr)); } while (0)
#define SWRITE_HK(bf) do { *(bf16x8*)(K_lds + (bf) * SHM_K + kws) = S.st_k0; *(bf16x8*)(K_lds + (bf) * SHM_K + kws + 32 * 256) = S.st_k1; } while (0)
#define SWRITE_HV(bf) do { *(bf16x8*)(V_lds + (bf) * SHM_V + vst0) = S.st_v0; *(bf16x8*)(V_lds + (bf) * SHM_V + vst1) = S.st_v1; } while (0)
#define SWRITE_H(bf) do { SWRITE_HV(bf); SWRITE_HK(bf); } while (0)
__device__ __forceinline__ void fox_prime(const BlockRef& cur, char* lds, Seam& S, const int wave_u, const int lane) {
    const int wid = wave_u, tid = wid * 64 + lane, r32 = lane & 31, hi = lane >> 5;
    const int sr = tid >> 4, sc = (tid & 15) * 8, kws = KSWZ(sr, sc * 2); char* K_lds = lds + 2 * SHM_V;
    for (int d0 = 0; d0 < 8; ++d0) S.qr[d0] = load8(cur.Q + (size_t)(wid * QBLK + r32) * D + d0 * 16 + hi * 8);
    SLOAD_H(cur.K, cur.V, cur.jlo * KVBLK); VMW(); SWRITE_HK(0);
    __syncthreads();
}
__device__ __forceinline__ void fox_block(const BlockRef& cur, const BlockRef& nxt, char* lds, Seam& S, const int wave_u, const int lane) {
    const int wid = wave_u, tid = wid * 64 + lane, r32 = lane & 31, hi = lane >> 5;
    const int j_lo = cur.jlo, NT = (cur.P0 + QB - 1) / KVBLK + 1 - j_lo;
    const int kbn = nxt.jlo * KVBLK;
    const int qlo = cur.P0 + wid * QBLK, qm = qlo + r32 - 4 * hi;
    char* V_lds = lds; char* K_lds = lds + 2 * SHM_V;
    float* ws = (float*)(lds + LDS_WS) + wid * 64; float* li_l = ws, * al_l = ws + 32;
    const FA_LAS float* fbh = (const FA_LAS float*)((FA_LAS char*)lds + LDS_FB) + 4 * hi;
    float m_reg = -1e30f, l_reg = 0; f32x16 o[4] = {};
    const int sr = tid >> 4, sc = (tid & 15) * 8, vst0 = v_st(sr, sc), vst1 = vst0 + 8192  , kws = KSWZ(sr, sc * 2);
    const int vb0 = (int)(uintptr_t)V_lds + v_rd_base(lane);
    const gcp Kh = cur.K; const gcp Vh = cur.V;
#define RESC(a) do { if (__any((a) < 1.f)) { if (hi == 0) al_l[r32] = (a); asm volatile("s_waitcnt lgkmcnt(0)" ::: "memory");              \
                     for (int d_ = 0; d_ < 4; ++d_) for (int r = 0; r < 16; ++r) o[d_][r] *= al_l[crow(r, hi)]; } } while (0)
#define KBASE(t) ((j_lo + (t)) * KVBLK)
#define MASKT(P0_, P1_, t) do { const int kb_ = KBASE(t); if (kb_ + KVBLK - 1 > qlo) mask_tile(P0_, P1_, qm - kb_, WBIG); } while (0)
    constexpr int NQL = 8;
#define SEAM_K0() do { VMWN(NQL); SWRITE_HK(0); SBAR(); } while (0)
    f32x16 pA0, pA1, pB0, pB1; float mnA, mnB, alA, alB; bf16x8 pa0, pa1, pa2, pa3;
    SWRITE_HV(0); SBAR();
    if (NT > 1) { SLOAD_H(Kh, Vh, KBASE(1)); }
    SBAR(); qkt<0>(pA0, pA1, K_lds, fbh + KBASE(0), r32, hi, S.qr);
    MASKT(pA0, pA1, 0); partialSM(pA0, pA1, m_reg, mnA, alA);
    if (NT > 1) { VMW(); SWRITE_H(1); }
    __syncthreads();
#define HALF_STEP(PX0, PX1, mnX, alX, PY0, PY1, alY, t, KB, VB, SB) do {                                                      \
        SBAR(); qkt<KB>(PX0, PX1, K_lds, fbh + KBASE(t), r32, hi, S.qr);                                         \
        finishSM(PY0, PY1, alY, l_reg, pa0, pa1, pa2, pa3); SBAR();                                                           \
        if ((t) + 1 < NT) { SLOAD_H(Kh, Vh, KBASE((t) + 1)); SBAR(); }                                               \
        pv_tile<VB>(o, vb0, pa0, pa1, pa2, pa3); MASKT(PX0, PX1, (t)); partialSM(PX0, PX1, m_reg, mnX, alX);                                        \
        __syncthreads();                                                                                                      \
        if ((t) + 1 < NT) { VMW(); SWRITE_H(SB); }                                                                          \
        RESC(alX); __syncthreads(); } while (0)
    for (int t = 1; t + 1 < NT; t += 2) {
        HALF_STEP(pB0, pB1, mnB, alB, pA0, pA1, alA, t, 1, 0, 0);
        HALF_STEP(pA0, pA1, mnA, alA, pB0, pB1, alB, t + 1, 0, 1, 1);
    }
    const bool even = (NT & 1) == 0;
    if (even) { SBAR(); qkt<1>(pB0, pB1, K_lds, fbh + KBASE(NT - 1), r32, hi, S.qr); SBAR(); }
    SLOAD_H(nxt.K, nxt.V, kbn); SBAR();
#pragma unroll
    for (int d0 = 0; d0 < 8; ++d0) S.qr[d0] = load8(nxt.Q + (size_t)(wid * QBLK + r32) * D + d0 * 16 + hi * 8);
    SBAR();
    finishSM(pA0, pA1, alA, l_reg, pa0, pa1, pa2, pa3); SBAR();
    pv_tile<0>(o, vb0, pa0, pa1, pa2, pa3);
    if (even) { MASKT(pB0, pB1, NT - 1); partialSM(pB0, pB1, m_reg, mnB, alB); __syncthreads(); RESC(alB);
        finishSM(pB0, pB1, alB, l_reg, pa0, pa1, pa2, pa3); SBAR(); pv_tile<1>(o, vb0, pa0, pa1, pa2, pa3); }
    SBAR(); SEAM_K0();
    if (hi == 0) li_l[r32] = l_reg; asm volatile("s_waitcnt lgkmcnt(0)" ::: "memory");
    float rli[16];
#pragma unroll
    for (int r = 0; r < 16; ++r) rli[r] = __builtin_amdgcn_rcpf(li_l[crow(r, hi)]);
    const gp Ow = cur.O + (size_t)(wid * QBLK) * OP;
#pragma unroll
    for (int r = 0; r < 16; ++r) { const int orow = crow(r, hi);
#pragma unroll
        for (int d0 = 0; d0 < 4; ++d0) { const float v = o[d0][r] * rli[r];
            const float vn = __shfl_xor(v, 1);
            if ((r32 & 1) == 0) *(FA_GAS unsigned*)(Ow + (size_t)orow * OP + d0 * 32 + r32) = cvtpk(v, vn); } }
    __syncthreads();
#undef RESC
#undef KBASE
#undef MASKT
#undef SEAM_K0
#undef HALF_STEP
}
#undef ROW
#undef VMW
#undef VMWN
#undef SLOAD_H
#undef SWRITE_HK
#undef SWRITE_HV
#undef SWRITE_H
#undef KSWZ
#undef SBAR
}

constexpr int NWAVES = 8, NTHREADS = 512;
constexpr int N_LAUNCHES = MK_N_LAUNCHES;
constexpr int N_PHASES = 7;
constexpr size_t MiB = 1u << 20;
constexpr size_t WS_SS = 0;
constexpr size_t WS_MRS = 48 * 1024;
constexpr size_t WS_BAR = 64 * 1024;
constexpr size_t WS_LF = 1 * MiB;
constexpr size_t WS_MACC = WS_LF + 512 * 1024;
constexpr size_t WS_WUP = 4 * MiB, WS_WDN = 36 * MiB, WS_WO = 68 * MiB, WS_WMIX = 76 * MiB;
constexpr size_t WS_WIN = 84 * MiB;
constexpr size_t WS_XN = 124 * MiB;
constexpr size_t WS_ACAT = WS_XN;
constexpr size_t WS_Q = 156 * MiB, WS_K = 172 * MiB, WS_V = 189 * MiB;
constexpr size_t WS_MG = WS_Q;
constexpr size_t WS_UB = 206 * MiB, WS_CB = 223 * MiB, WS_G = 239 * MiB;
constexpr size_t WS_H1G = WS_G;
constexpr size_t WS_XN8 = WS_WUP;
constexpr size_t WS_WG8 = WS_WDN;
constexpr size_t WS_UU = WS_WIN;
constexpr size_t WS_END = 303 * MiB;
static_assert(WS_UU + (size_t)MROWS * DFF * 2 <= WS_G && WS_K + (size_t)NB * NH * LP * HD * 2 <= WS_V && WS_V + (size_t)NB * NH * LP * HD * 2 <= WS_UB &&
              WS_UB + (size_t)NB * UBR * CW * 2 <= WS_CB && WS_G + (size_t)MROWS * 2 * DM * 2 <= WS_END && WS_MG + (size_t)MROWS * DM * 2 <= WS_V, "d_ws map");
constexpr int RING_BYTES = 131072, SCR_OFF = RING_BYTES, LDS_BYTES = 147456;
static_assert(fa::LDS_BYTES <= RING_BYTES, "attention LDS");

#define LAS __attribute__((address_space(3)))
typedef unsigned short bf16;
typedef unsigned v4u __attribute__((ext_vector_type(4)));
typedef float f32x4 __attribute__((ext_vector_type(4)));
__device__ __forceinline__ unsigned f2bf(float f) { unsigned u = __builtin_bit_cast(unsigned, f); return (u + 0x7fffu + ((u >> 16) & 1u)) >> 16; }
__device__ __forceinline__ unsigned pk2(float lo, float hi) { return pg8::cvt_pk_bf16(lo, hi); }
__device__ __forceinline__ float wave_sum(float v) {
#pragma unroll
    for (int o = 1; o < 64; o <<= 1) v += __shfl_xor(v, o);
    return v;
}


#define XB_TMO      128
#define XB_XCNT(j)  (256  + 64 * (j))
#define XB_XSUB(j)  (1280 + 64 * (j))
#define XB_XGEN(j)  (2304 + 64 * (j))
#define XB_TOP      3328
#define XB_TOPGEN   3392
#define XCD_BAR_WORDS 3456
#define XB_SPIN_CAP (1u << 22)
__device__ __forceinline__ unsigned xb_ld(unsigned* p)              { return __hip_atomic_load(p, __ATOMIC_RELAXED, __HIP_MEMORY_SCOPE_AGENT); }
__device__ __forceinline__ unsigned xb_add(unsigned* p, unsigned v) { return __hip_atomic_fetch_add(p, v, __ATOMIC_RELAXED, __HIP_MEMORY_SCOPE_AGENT); }
__device__ __forceinline__ unsigned xb_xcc_id() { return (unsigned)__builtin_amdgcn_s_getreg((3 << 11) | 20) & 0xFu; }
#define XB_SPIN(cond, bar) do { unsigned _sp = 0; while (cond) { __builtin_amdgcn_s_sleep(4); \
    if ((++_sp & 255u) == 0u) { if (xb_ld(&(bar)[XB_TMO])) break; if (_sp > XB_SPIN_CAP) { atomicAdd(&(bar)[XB_TMO], 1u); break; } } } } while (0)
struct XcdBarrier { unsigned* bar; unsigned x; volatile LAS unsigned* st; };
__device__ __forceinline__ XcdBarrier xcd_barrier_post(unsigned* bar, volatile LAS unsigned* st, bool leader) {
    XcdBarrier b; b.bar = bar; b.x = xb_xcc_id(); b.st = st;
    if (leader) (void)xb_add(&bar[XB_XCNT(b.x)], 1u);
    return b;
}
__device__ __forceinline__ void xcd_barrier_complete(unsigned* bar, unsigned x, unsigned& nloc, unsigned& nx) {
    const unsigned G = gridDim.x * gridDim.y * gridDim.z;
    unsigned sum, cnt, mine, sp = 0u;
    for (;;) {
        sum = 0u; cnt = 0u; mine = 0u;
#pragma unroll
        for (unsigned j = 0; j < 16; ++j) { const unsigned c = xb_ld(&bar[XB_XCNT(j)]); sum += c; cnt += (c > 0u) ? 1u : 0u; mine = (j == x) ? c : mine; }
        if (sum == G) break;
        __builtin_amdgcn_s_sleep(1);
        if ((++sp & 255u) == 0u) { if (xb_ld(&bar[XB_TMO])) break; if (sp > XB_SPIN_CAP) { atomicAdd(&bar[XB_TMO], 1u); break; } }
    }
    nloc = mine > 0u ? mine : 1u; nx = cnt > 0u ? cnt : 1u;
}
__device__ __forceinline__ void xcd_barrier(const XcdBarrier& b, bool leader) {
    asm volatile("s_waitcnt vmcnt(0)" ::: "memory");
    __syncthreads();
    if (leader) {
        unsigned* bar = b.bar;
        __builtin_amdgcn_s_waitcnt(0);
        unsigned nloc = b.st[0], nx = b.st[1];
        if (nloc == 0u) { xcd_barrier_complete(bar, b.x, nloc, nx); b.st[0] = nloc; b.st[1] = nx; }
        const unsigned old = xb_add(&bar[XB_XSUB(b.x)], 1u);
        const unsigned gen = old / nloc;
        if (old + 1u == (gen + 1u) * nloc) {
            __builtin_amdgcn_fence(__ATOMIC_RELEASE, "agent");
            asm volatile("s_waitcnt vmcnt(0)" ::: "memory");
            const unsigned og = xb_add(&bar[XB_TOP], 1u);
            const unsigned tg = og / nx;
            if (og + 1u == (tg + 1u) * nx) xb_add(&bar[XB_TOPGEN], 1u);
            else XB_SPIN(xb_ld(&bar[XB_TOPGEN]) == tg, bar);
            __builtin_amdgcn_fence(__ATOMIC_ACQUIRE, "agent");
            xb_add(&bar[XB_XGEN(b.x)], 1u);
            asm volatile("s_waitcnt vmcnt(0)" ::: "memory");
        } else {
            XB_SPIN(xb_ld(&bar[XB_XGEN(b.x)]) == gen, bar);
            __builtin_amdgcn_fence(__ATOMIC_ACQUIRE, "agent");
            asm volatile("s_waitcnt vmcnt(0)" ::: "memory");
        }
    }
    __syncthreads();
}

struct Args {
    const float *x, *meta, *norm_mix, *w_in, *b_fgate, *b_gate, *q_norm, *k_norm, *conv_w, *w_attn_out, *w_conv_out, *w_o, *norm_mlp, *w_up, *w_down;
    float* out; unsigned char* ws; int ph_lo, ph_hi;
};

__device__ __forceinline__ int win_src_col(int n) {
    if (n < 3072) return n;
    if (n < 5120) { const int k = (n - 3072) >> 8, w = (n - 3072) & 255; return w < 128 ? 4104 + 128 * k + w : 5128 + 128 * k + (w - 128); }
    if (n < 6144) return 3080 + (n - 5120);
    return n + 8;
}
constexpr int TR_SCR_BYTES = 64 * 65 * 4;
template <bool NT = false, bool NTL = NT>
__device__ __forceinline__ void tr_item(const float* W, int ldw, int cs, int k0, bf16* WT, int ldt, int nd, int kd, LAS float* scr, int lane, const float* kscale = nullptr) {
    const int r = lane >> 4, c4 = lane & 15;
    f32x4 v[16];
    const float* src = W + (size_t)(k0 + r) * ldw + cs + 4 * c4;
#pragma unroll
    for (int i = 0; i < 16; ++i) { if constexpr (NTL) v[i] = __builtin_nontemporal_load((const f32x4*)(src + (size_t)(4 * i) * ldw)); else v[i] = *(const f32x4*)(src + (size_t)(4 * i) * ldw); }
    if (kscale) {
#pragma unroll
        for (int i = 0; i < 16; ++i) v[i] = v[i] * kscale[k0 + 4 * i + r]; }
#pragma unroll
    for (int i = 0; i < 16; ++i) { LAS float* d = scr + (4 * i + r) * 65 + 4 * c4; d[0] = v[i][0]; d[1] = v[i][1]; d[2] = v[i][2]; d[3] = v[i][3]; }
    asm volatile("s_waitcnt lgkmcnt(0)" ::: "memory");
    const int c = lane & 7;
#pragma unroll
    for (int j = 0; j < 8; ++j) { const int n = (lane >> 3) + 8 * j; const LAS float* s = scr + (8 * c) * 65 + n;
        v4u o; o.x = pk2(s[0 * 65], s[1 * 65]); o.y = pk2(s[2 * 65], s[3 * 65]); o.z = pk2(s[4 * 65], s[5 * 65]); o.w = pk2(s[6 * 65], s[7 * 65]);
        if constexpr (NT) __builtin_nontemporal_store(o, (v4u*)(WT + (size_t)(nd + n) * ldt + kd + 8 * c)); else *(v4u*)(WT + (size_t)(nd + n) * ldt + kd + 8 * c) = o; }
    asm volatile("s_waitcnt lgkmcnt(0)" ::: "memory");
}

__device__ __forceinline__ unsigned pk4_fp8(float a, float b, float c, float d) { unsigned w = 0u; w = __builtin_amdgcn_cvt_pk_fp8_f32(a, b, w, false); w = __builtin_amdgcn_cvt_pk_fp8_f32(c, d, w, true); return w; }
__device__ __forceinline__ void tr_item_fp8(const float* W, int ldw, int cs, int k0, unsigned char* WT8, int ldt, int nd, int kd, LAS float* scr, int lane, float scale) {
    const int r = lane >> 4, c4 = lane & 15;
    f32x4 v[16];
    const float* src = W + (size_t)(k0 + r) * ldw + cs + 4 * c4;
#pragma unroll
    for (int i = 0; i < 16; ++i) v[i] = __builtin_nontemporal_load((const f32x4*)(src + (size_t)(4 * i) * ldw));
#pragma unroll
    for (int i = 0; i < 16; ++i) { LAS float* d = scr + (4 * i + r) * 65 + 4 * c4; d[0] = v[i][0] * scale; d[1] = v[i][1] * scale; d[2] = v[i][2] * scale; d[3] = v[i][3] * scale; }
    asm volatile("s_waitcnt lgkmcnt(0)" ::: "memory");
    const int c = lane & 3;
#pragma unroll
    for (int j = 0; j < 4; ++j) { const int n = (lane >> 2) + 16 * j; const LAS float* s = scr + (16 * c) * 65 + n;
        v4u o; o.x = pk4_fp8(s[0 * 65], s[1 * 65], s[2 * 65], s[3 * 65]); o.y = pk4_fp8(s[4 * 65], s[5 * 65], s[6 * 65], s[7 * 65]);
        o.z = pk4_fp8(s[8 * 65], s[9 * 65], s[10 * 65], s[11 * 65]); o.w = pk4_fp8(s[12 * 65], s[13 * 65], s[14 * 65], s[15 * 65]);
        *(v4u*)(WT8 + (size_t)(nd + n) * ldt + kd + 16 * c) = o; }
    asm volatile("s_waitcnt lgkmcnt(0)" ::: "memory");
}

__device__ __forceinline__ int meta_group_col(int g) { return g < 8 ? 1024 + 128 * g : g < 16 ? 2048 + 128 * (g - 8) : g < 24 ? 4104 + 128 * (g - 16) : 5128 + 128 * (g - 24); }
__device__ __forceinline__ void meta_partial(const Args& a, int sub, LAS unsigned char* lds, int tid) {
    const int g = sub >> 3, kc = sub & 7, col0 = meta_group_col(g), c = tid & 127, kq = tid >> 7;
    LAS float* mx = (LAS float*)lds;
    LAS float* red = (LAS float*)(lds + 16384);
    float w[64];
#pragma unroll
    for (int i = 0; i < 64; ++i) w[i] = __builtin_nontemporal_load(a.w_in + (size_t)(kc * 256 + kq * 64 + i) * INC + col0 + c);
    for (int i = tid; i < 16 * 256; i += NTHREADS) { const int r = i >> 8, d = kc * 256 + (i & 255); mx[i] = a.meta[r * DM + d] * a.norm_mix[d]; }
    __syncthreads();
    float acc[16];
#pragma unroll
    for (int r = 0; r < 16; ++r) { float s = 0.f;
#pragma unroll
        for (int i = 0; i < 64; i += 4) { const f32x4 m = *(const LAS f32x4*)(mx + r * 256 + kq * 64 + i); s += (m[0] * w[i] + m[1] * w[i + 1]) + (m[2] * w[i + 2] + m[3] * w[i + 3]); }
        acc[r] = s; }
#pragma unroll
    for (int r = 0; r < 16; ++r) red[(kq * 16 + r) * 128 + c] = acc[r];
    __syncthreads();
    float* MACC = (float*)(a.ws + WS_MACC) + ((size_t)kc * 32 + g) * 2048;
    for (int i = tid; i < 2048; i += NTHREADS) MACC[i] = (red[i] + red[2048 + i]) + (red[4096 + i] + red[6144 + i]);
    __syncthreads();
}
__device__ __forceinline__ void meta_final(const Args& a, int task, int tid) {
    const float* MACC = (const float*)(a.ws + WS_MACC); const float* rs = (const float*)(a.ws + WS_MRS);
#define MSUM(p, i) (((p)[(i)] + (p)[(i) + 65536]) + ((p)[(i) + 2 * 65536] + (p)[(i) + 3 * 65536]) + (((p)[(i) + 4 * 65536] + (p)[(i) + 5 * 65536]) + ((p)[(i) + 6 * 65536] + (p)[(i) + 7 * 65536])))
    bf16* Kb = (bf16*)(a.ws + WS_K); bf16* Vb = (bf16*)(a.ws + WS_V); bf16* UB = (bf16*)(a.ws + WS_UB);
    const int lane = tid & 63, wave = tid >> 6, kind = task >> 3, idx = task & 7;
    if (kind == 0) {
        const float* m = MACC + (size_t)idx * 2048;
        for (int r = wave * 2; r < wave * 2 + 2; ++r) { const float v0 = MSUM(m, r * 128 + lane) * rs[r], v1 = MSUM(m, r * 128 + 64 + lane) * rs[r];
            const float ss = wave_sum(v0 * v0 + v1 * v1); const float rstd = rsqrtf(ss * (1.0f / HD) + EPS);
            for (int b = 0; b < NB; ++b) { bf16* dst = Kb + ((size_t)(b * NH + idx) * LP + r) * HD;
                dst[lane] = (bf16)f2bf(v0 * rstd * a.k_norm[lane]); dst[64 + lane] = (bf16)f2bf(v1 * rstd * a.k_norm[64 + lane]); } }
    } else if (kind == 1) {
        const float* m = MACC + (size_t)(8 + idx) * 2048;
        for (int i = tid; i < 2048; i += NTHREADS) { const int r = i >> 7, c = i & 127; const unsigned short v = (unsigned short)f2bf(MSUM(m, i) * rs[r]);
            for (int b = 0; b < NB; ++b) Vb[((size_t)(b * NH + idx) * LP + r) * HD + c] = v; }
    } else {
        const float* mc = MACC + (size_t)(16 + idx) * 2048; const float* mxx = MACC + (size_t)(24 + idx) * 2048;
        for (int i = tid; i < 256; i += NTHREADS) { const int r = 14 + (i >> 7), c = i & 127; const float u = (MSUM(mc, r * 128 + c) * rs[r]) * (MSUM(mxx, r * 128 + c) * rs[r]);
            for (int b = 0; b < NB; ++b) UB[((size_t)b * UBR + (r - 14)) * CW + 128 * idx + c] = (bf16)f2bf(u); }
    }
}

__device__ __forceinline__ void norm_row(const Args& a, const float* xrow, bf16* xn_out, unsigned* xn8_out, float* lf0, float* lf1, float* rs_out, const LAS float* wf, int lane) {
    f32x4 v[8]; float s = 0.f;
#pragma unroll
    for (int j = 0; j < 8; ++j) { v[j] = __builtin_nontemporal_load((const f32x4*)xrow + lane + 64 * j); s += (v[j][0] * v[j][0] + v[j][1] * v[j][1]) + (v[j][2] * v[j][2] + v[j][3] * v[j][3]); }
    const float rstd = rsqrtf(wave_sum(s) * (1.0f / DM) + EPS);
    if (rs_out && lane == 0) *rs_out = rstd;
    float fg[8];
#pragma unroll
    for (int q = 0; q < 8; ++q) fg[q] = 0.f;
#pragma unroll
    for (int j = 0; j < 8; ++j) { const f32x4 g = *((const f32x4*)a.norm_mix + lane + 64 * j); v[j] = v[j] * rstd * g;
        if (xn_out) { *((unsigned long long*)xn_out + lane + 64 * j) = (unsigned long long)pk2(v[j][0], v[j][1]) | ((unsigned long long)pk2(v[j][2], v[j][3]) << 32);
                      xn8_out[lane + 64 * j] = pk4_fp8(v[j][0], v[j][1], v[j][2], v[j][3]); }
#pragma unroll
        for (int i = 0; i < 4; ++i) { const LAS f32x4* wp = (const LAS f32x4*)wf + ((j * 4 + i) * 2) * 64 + lane; const f32x4 w0 = wp[0], w1 = wp[64];
            fg[0] += v[j][i] * w0[0]; fg[1] += v[j][i] * w0[1]; fg[2] += v[j][i] * w0[2]; fg[3] += v[j][i] * w0[3];
            fg[4] += v[j][i] * w1[0]; fg[5] += v[j][i] * w1[1]; fg[6] += v[j][i] * w1[2]; fg[7] += v[j][i] * w1[3]; } }
#pragma unroll
    for (int q = 0; q < 8; ++q) fg[q] = wave_sum(fg[q]);
    if (lane < 8) { float z = fg[0];
#pragma unroll
        for (int q = 1; q < 8; ++q) z = (lane == q) ? fg[q] : z;
        z += a.b_fgate[lane];
        const float ls = fminf(z, 0.f) - log1pf(expf(-fabsf(z)));
        lf0[lane] = ls; if (lf1) lf1[lane] = ls; }
}

__device__ __forceinline__ void p0_prologue(const Args& a, LAS unsigned char* lds, int tid, int G, bool entry_sync) {
    const int lane = tid & 63, wave = __builtin_amdgcn_readfirstlane(tid >> 6);
    const int gw = blockIdx.x * NWAVES + wave, NGW = G * NWAVES, gt = blockIdx.x * NTHREADS + tid, NGT = G * NTHREADS;
    unsigned char* ws = a.ws;
    for (int i = gt; i < MROWS; i += NGT) ((float*)(ws + WS_SS))[i] = 0.f;
    for (int i = gt; i < NB * NH * (LP - LTOT) * HD / 8; i += NGT) { const int bh = i / ((LP - LTOT) * HD / 8), r = i % ((LP - LTOT) * HD / 8);
        const size_t off = ((size_t)bh * LP + LTOT) * HD + (size_t)r * 8; *(v4u*)((bf16*)(ws + WS_K) + off) = (v4u){0u, 0u, 0u, 0u}; *(v4u*)((bf16*)(ws + WS_V) + off) = (v4u){0u, 0u, 0u, 0u}; }
    for (int sub = blockIdx.x; sub < 256; sub += G) meta_partial(a, sub, lds, tid);
    if (entry_sync) {
        if (blockIdx.x == 0) for (int i = tid; i < XCD_BAR_WORDS; i += NTHREADS) ((unsigned*)(a.ws + WS_BAR))[i] = 0u;
        cg::this_grid().sync();
        (void)xcd_barrier_post((unsigned*)(a.ws + WS_BAR), (volatile LAS unsigned*)(lds + SCR_OFF + 8192), tid == 0);
    }
    __syncthreads();
    {
        bf16* WIN = (bf16*)(ws + WS_WIN); unsigned char* WG8 = ws + WS_WG8; LAS float* scr = (LAS float*)(lds + wave * TR_SCR_BYTES);
        constexpr int NBF = 6144, I_BF = (DM / 64) * (NBF / 64), I_G8 = (DM / 64) * ((NIN - NBF) / 64);
        for (int it = gw; it < I_BF + I_G8; it += NGW) {
            if (it < I_BF) { const int kb = it % (DM / 64), nb = it / (DM / 64); tr_item<false, true>(a.w_in, INC, win_src_col(64 * nb), 64 * kb, WIN, DM, 64 * nb, 64 * kb, scr, lane); }
            else { const int r = it - I_BF, kb = r % (DM / 64), nb = r / (DM / 64), n0 = 64 * nb, gk = n0 >> 8, gw_ = n0 & 255;
                   const int src = 6152 + (gw_ < 128 ? 128 * gk + gw_ : DM + 128 * gk + (gw_ - 128));
                   tr_item_fp8(a.w_in, INC, src, 64 * kb, WG8, DM, n0, 64 * kb, scr, lane, WG_SCALE); }
        }
    }
    __syncthreads();
    LAS float* wf = (LAS float*)lds;
    for (int i = tid; i < DM * 8; i += NTHREADS) { const int d = i >> 3, q = i & 7, ln = (d & 255) >> 2, ii = d & 3, j = d >> 8;
        wf[((((j * 4 + ii) * 2 + (q >> 2)) * 64 + ln) << 2) + (q & 3)] = a.w_in[(size_t)d * INC + 3072 + q]; }
    __syncthreads();
    float* LF = (float*)(ws + WS_LF); bf16* XN = (bf16*)(ws + WS_XN);
    for (int R = gw; R < MROWS + NMETA; R += NGW) {
        if (R < MROWS) { const int b = R / SEQ, t = R % SEQ; norm_row(a, a.x + (size_t)R * DM, XN + (size_t)R * DM, (unsigned*)(ws + WS_XN8 + (size_t)R * DM), LF + ((size_t)b * LTOT + NMETA + t) * 8, nullptr, nullptr, wf, lane); }
        else { const int r = R - MROWS; norm_row(a, a.meta + (size_t)r * DM, nullptr, nullptr, LF + (size_t)r * 8, LF + ((size_t)LTOT + r) * 8, (float*)(ws + WS_MRS) + r, wf, lane); }
    }
}

#define TR_MAP(r, nkb, nnb, kb, nb) const int kbl_ = (nkb) < 32 ? (nkb) : 32, kb = ((r) % kbl_) + kbl_ * ((r) / (kbl_ * (nnb))), nb = ((r) / kbl_) % (nnb)
__device__ __forceinline__ void tr_others(const Args& a, LAS unsigned char* lds, int it_lo, int it_hi, int wave, int lane) {
    unsigned char* ws = a.ws;
    LAS float* scr = (LAS float*)(lds + wave * TR_SCR_BYTES);
    bf16* WMIX = (bf16*)(ws + WS_WMIX); bf16* WO = (bf16*)(ws + WS_WO); bf16* WUP = (bf16*)(ws + WS_WUP); bf16* WDN = (bf16*)(ws + WS_WDN);
    constexpr int I_AO = (AW / 64) * (DM / 64), I_CO = I_AO, I_O = (DM / 64) * (DM / 64), I_UP = (DM / 64) * (DFF / 64), I_DN = (DFF / 64) * (DM / 64);
    for (int it = it_lo + wave; it < it_hi; it += NWAVES) {
        int r = it;
        if (r < I_AO) { TR_MAP(r, AW / 64, DM / 64, kb, nb); tr_item<true>(a.w_attn_out, DM, 64 * nb, 64 * kb, WMIX, 2 * AW, 64 * nb, 64 * kb, scr, lane); continue; } r -= I_AO;
        if (r < I_CO) { TR_MAP(r, AW / 64, DM / 64, kb, nb); tr_item<true>(a.w_conv_out, DM, 64 * nb, 64 * kb, WMIX, 2 * AW, 64 * nb, AW + 64 * kb, scr, lane); continue; } r -= I_CO;
        if (r < I_O) { TR_MAP(r, DM / 64, DM / 64, kb, nb); tr_item<true>(a.w_o, DM, 64 * nb, 64 * kb, WO, DM, 64 * nb, 64 * kb, scr, lane); continue; } r -= I_O;
        if (r < I_UP) { TR_MAP(r, DM / 64, DFF / 64, kb, nb); tr_item<true>(a.w_up, DFF, 64 * nb, 64 * kb, WUP, DM, 64 * nb, 64 * kb, scr, lane, a.norm_mlp); continue; } r -= I_UP;
        { TR_MAP(r, DFF / 64, DM / 64, kb, nb); tr_item<true>(a.w_down, DM, 64 * nb, 64 * kb, WDN, DFF, 64 * nb, 64 * kb, scr, lane); }
    }
}

__device__ __forceinline__ void conv_phase(const Args& a, int tid, int c_lo, int c_hi) {
    const bf16* UB = (const bf16*)(a.ws + WS_UB); const bf16* CB = (const bf16*)(a.ws + WS_CB); bf16* AC = (bf16*)(a.ws + WS_ACAT);
    for (int item = c_lo + tid; item < c_hi; item += NTHREADS) {
        const int rg = item / (CW / 8), cgp = item % (CW / 8), b = rg / (SEQ / 8), t0 = (rg % (SEQ / 8)) * 8, ch = cgp * 8;
        f32x4 w[3][2];
#pragma unroll
        for (int j = 0; j < 3; ++j) { w[j][0] = *(const f32x4*)(a.conv_w + j * CW + ch); w[j][1] = *(const f32x4*)(a.conv_w + j * CW + ch + 4); }
        v4u ur[10], cr[8];
#pragma unroll
        for (int i = 0; i < 10; ++i) ur[i] = __builtin_nontemporal_load((const v4u*)(UB + ((size_t)b * UBR + t0 + i) * CW + ch));
#pragma unroll
        for (int i = 0; i < 8; ++i) cr[i] = __builtin_nontemporal_load((const v4u*)(CB + ((size_t)b * SEQ + t0 + i) * CW + ch));
        f32x4 u0a, u0b, u1a, u1b, u2a, u2b;
        pg8::unpack8(ur[0], u0a, u0b); pg8::unpack8(ur[1], u1a, u1b);
#pragma unroll
        for (int i = 0; i < 8; ++i) {
            pg8::unpack8(ur[i + 2], u2a, u2b);
            const size_t R = (size_t)b * SEQ + t0 + i; f32x4 ca, cb2; pg8::unpack8(cr[i], ca, cb2);
            const f32x4 ya = w[0][0] * u0a + w[1][0] * u1a + w[2][0] * u2a, yb = w[0][1] * u0b + w[1][1] * u1b + w[2][1] * u2b;
            *(v4u*)(AC + R * (2 * AW) + AW + ch) = pg8::pack8(ca * ya, cb2 * yb);
            u0a = u1a; u0b = u1b; u1a = u2a; u1b = u2b;
        }
    }
}

__device__ __forceinline__ fa::BlockRef fox_ref(const Args& a, int bh, int qb) {
    fa::BlockRef r; const int b = bh >> 3, h = bh & 7;
    r.Q = (fa::gcp)(a.ws + WS_Q) + ((size_t)bh * SEQ + (size_t)qb * fa::QB) * HD;
    r.K = (fa::gcp)(a.ws + WS_K) + (size_t)bh * LP * HD; r.V = (fa::gcp)(a.ws + WS_V) + (size_t)bh * LP * HD;
    r.O = (fa::gp)(a.ws + WS_ACAT) + ((size_t)b * SEQ + (size_t)qb * fa::QB) * fa::OP + h * HD;
    r.P0 = NMETA + qb * fa::QB; r.jlo = 0;
    return r;
}
__device__ __forceinline__ void fox_bias(const Args& a, int bh, char* lds, int tid) {
    const int b = bh >> 3, h = bh & 7, lane = tid & 63, wave = tid >> 6;
    const float* LF = (const float*)(a.ws + WS_LF) + (size_t)b * LTOT * 8 + h;
    float* fb = (float*)(lds + fa::LDS_FB); float* wt = (float*)(lds + fa::LDS_SCAN);
    float v[9]; float s = 0.f;
#pragma unroll
    for (int k = 0; k < 9; ++k) { const int p = 9 * tid + k; const float x = p < LTOT ? LF[(size_t)p * 8] : 0.f; s += x; v[k] = s; }
    float inc = s;
#pragma unroll
    for (int o = 1; o < 64; o <<= 1) { const float t = __shfl_up(inc, o); if (lane >= o) inc += t; }
    if (lane == 63) wt[wave] = inc;
    __syncthreads();
    float base = inc - s;
    for (int w = 0; w < wave; ++w) base += wt[w];
#pragma unroll
    for (int k = 0; k < 9; ++k) { const int p = 9 * tid + k; if (p < LP) fb[p] = p < LTOT ? -(base + v[k]) * LOG2E : 0.f; }
    __syncthreads();
}
__device__ __forceinline__ int fox_jlo(const float* fb, int P0, float th) {
    const float lim = fb[P0] - th; const int jmax = (P0 + fa::QB - 1) / fa::KVBLK;
    int j = 0; while (j < jmax && fb[64 * j + 63] < lim) ++j;
    return __builtin_amdgcn_readfirstlane(j);
}
__device__ __forceinline__ void attn_phase(const Args& a, char* lds, int tid, int G, const int wave_u) {
    const int lane = tid & 63;
    float gq = fmaxf(fabsf(a.q_norm[lane]), fabsf(a.q_norm[64 + lane])), gk = fmaxf(fabsf(a.k_norm[lane]), fabsf(a.k_norm[64 + lane]));
#pragma unroll
    for (int o = 1; o < 64; o <<= 1) { gq = fmaxf(gq, __shfl_xor(gq, o)); gk = fmaxf(gk, __shfl_xor(gk, o)); }
    const float th = 40.f + 2.f * (128.f * QSCALE * 1.02f) * gq * gk;
    const int L = blockIdx.x;
    if (L < NB * NH * (SEQ / fa::QB)) {
        const int xcd = L & 7, k = L >> 3, bh = xcd * 2 + (k >> 4), qb = k & 15;
        fox_bias(a, bh, lds, tid);
        fa::Seam S;
        fa::BlockRef cur = fox_ref(a, bh, qb);
        cur.jlo = fox_jlo((const float*)(lds + fa::LDS_FB), cur.P0, th);
        asm volatile("" : "+s"(cur.K), "+s"(cur.V), "+s"(cur.Q), "+s"(cur.O), "+s"(cur.P0), "+s"(cur.jlo));
        fa::fox_prime(cur, lds, S, wave_u, tid & 63);
        fa::BlockRef nxt = cur;
        asm volatile("" : "+s"(nxt.K), "+s"(nxt.V), "+s"(nxt.Q), "+s"(nxt.O), "+s"(nxt.P0), "+s"(nxt.jlo));
        fa::fox_block(cur, nxt, lds, S, wave_u, tid & 63);
    }
}

__global__ void __launch_bounds__(NTHREADS, 2) fwd_kernel(Args a) {
    extern __shared__ __attribute__((aligned(16))) unsigned char lds_raw[];
    LAS unsigned char* lds = (LAS unsigned char*)lds_raw;
    const int wave_u = __builtin_amdgcn_readfirstlane((int)threadIdx.x >> 6), G = gridDim.x;
#define KTID (wave_u * 64 + lane_now())
    const int lo = a.ph_lo, hi = a.ph_hi;
    unsigned char* ws = a.ws;
#define IN(k) (lo <= (k) && (k) < hi)
    volatile LAS unsigned* MISC = (volatile LAS unsigned*)(lds + SCR_OFF + 8192);
    { const int t_ = KTID; if (t_ < 2) MISC[t_] = 0u; }
    __syncthreads();
#define SEAM(k) do { if (IN(k) && IN((k) + 1)) { { XcdBarrier bar_; bar_.bar = (unsigned*)(a.ws + WS_BAR); bar_.x = xb_xcc_id(); bar_.st = (volatile LAS unsigned*)(lds + SCR_OFF + 8192); xcd_barrier(bar_, KTID == 0); } } } while (0)
    if (IN(0)) { p0_prologue(a, lds, KTID, G, hi - lo > 1); }
    SEAM(0);
    if (IN(1)) {
        for (int task = blockIdx.x; task < 24; task += G) meta_final(a, task, KTID);
        {
            pg8::Gemm g{(const bf16*)(ws + WS_XN), (const bf16*)(ws + WS_WIN), DM, DM}; pg8::StaticOrder S; S.init(MROWS, 6144, G, (int)blockIdx.x);
            pg8::EpiInProj E{(bf16*)(ws + WS_Q), (bf16*)(ws + WS_K), (bf16*)(ws + WS_V), (bf16*)(ws + WS_UB), (bf16*)(ws + WS_CB), a.q_norm, a.k_norm, (LAS float*)(lds + SCR_OFF)};
            pg8::gemm_phase<pg8::EpiInProj, pg8::StaticOrder, true, true>(lds, g, S, E, wave_u);
        }
        {
            pg8::Gemm g{(const bf16*)(ws + WS_XN8), (const bf16*)(ws + WS_WG8), DM / 2, DM / 2}; pg8::StaticOrder S; S.init(MROWS, 2 * DM, G, (int)blockIdx.x);
            pg8::EpiGate E{(bf16*)(ws + WS_G), a.b_gate};
            pg8::gemm_phase<pg8::EpiGate, pg8::StaticOrder, true, true, true>(lds, g, S, E, wave_u);
        }
    }
    SEAM(1);
    if (IN(2)) {
        constexpr int N_CONV = (MROWS / 8) * (CW / 8), N_TR = 2 * (AW / 64) * (DM / 64) + (DM / 64) * (DM / 64) + 2 * (DM / 64) * (DFF / 64);
        const int k_ = (int)blockIdx.x >> 3, x_ = (int)blockIdx.x & 7;
        auto wq = [](int qb) { return qb == 0 ? 56 : qb == 1 ? 50 : qb == 2 ? 44 : qb == 3 ? 38 : 34; };
        int cum = 0; for (int kk = 0; kk < k_; ++kk) cum += wq(kk & 15);
        constexpr int WTOT = 8 * 2 * (56 + 50 + 44 + 38 + 12 * 34);
        const long p0 = 8L * cum + (long)x_ * wq(k_ & 15), p1 = p0 + wq(k_ & 15);
        const int c_lo = (int)(p0 * N_CONV / WTOT), c_hi = (int)(p1 * N_CONV / WTOT), t_lo = (int)(p0 * N_TR / WTOT), t_hi = (int)(p1 * N_TR / WTOT);
        const bool side_first = (k_ & 1) != 0;
        if (side_first) {
            conv_phase(a, KTID, c_lo, c_hi);
            tr_others(a, lds, t_lo, t_hi, wave_u, lane_now());
            __syncthreads();
        }
        attn_phase(a, (char*)lds_raw, KTID, G, wave_u);
        if (!side_first) {
            __syncthreads();
            conv_phase(a, KTID, c_lo, c_hi);
            tr_others(a, lds, t_lo, t_hi, wave_u, lane_now());
        }
    }
    SEAM(2);
    if (IN(3)) {
        pg8::Gemm g{(const bf16*)(ws + WS_ACAT), (const bf16*)(ws + WS_WMIX), 2 * AW, 2 * AW}; pg8::StaticOrder S; S.init(MROWS, DM, G, (int)blockIdx.x);
        pg8::EpiMix E{(const bf16*)(ws + WS_G), (bf16*)(ws + WS_MG)};
        pg8::gemm_phase<pg8::EpiMix, pg8::StaticOrder, true, true>(lds, g, S, E, wave_u);
    }
    SEAM(3);
    if (IN(4)) {
        pg8::Gemm g{(const bf16*)(ws + WS_MG), (const bf16*)(ws + WS_WO), DM, DM}; pg8::StaticOrder S; S.init(MROWS, DM, G, (int)blockIdx.x);
        pg8::EpiWo E{a.x, (bf16*)(ws + WS_H1G), (float*)(ws + WS_SS)};
        pg8::gemm_phase<pg8::EpiWo, pg8::StaticOrder, true, true>(lds, g, S, E, wave_u);
    }
    SEAM(4);
    if (IN(5)) {
        pg8::Gemm g{(const bf16*)(ws + WS_H1G), (const bf16*)(ws + WS_WUP), DM, DM}; pg8::StaticOrder S; S.init(MROWS, DFF, G, (int)blockIdx.x);
        pg8::EpiUp E{(const float*)(ws + WS_SS), (bf16*)(ws + WS_UU)};
        pg8::gemm_phase<pg8::EpiUp, pg8::StaticOrder, true, true>(lds, g, S, E, wave_u);
    }
    SEAM(5);
    if (IN(6)) {
        pg8::Gemm g{(const bf16*)(ws + WS_UU), (const bf16*)(ws + WS_WDN), DFF, DFF}; pg8::StaticOrder S; S.init(MROWS, DM, G, (int)blockIdx.x);
        pg8::EpiDown E{(const bf16*)(ws + WS_H1G), a.out};
        pg8::gemm_phase<pg8::EpiDown, pg8::StaticOrder, true, true>(lds, g, S, E, wave_u);
    }
#undef IN
#undef SEAM
}

extern "C" void kernel_launch(void* const* d_in, const int* in_sizes, int n_in, void* d_out, int out_size, void* d_ws, size_t ws_size, hipStream_t stream) {
    static int grid = 0;
    if (grid == 0) {
        if (n_in != 15 || in_sizes[0] != MROWS * DM || out_size != MROWS * DM || ws_size < WS_END) {
            fprintf(stderr, "kernel_launch: unexpected shapes (n_in %d, in0 %d, out %d, ws %zu; need ws >= %zu); nothing launched\n", n_in, n_in > 0 ? in_sizes[0] : -1, out_size, ws_size, (size_t)WS_END); grid = -1; return; }
        int dev = 0, cus = 0, per_cu = 0;
        if (hipGetDevice(&dev) != hipSuccess || hipDeviceGetAttribute(&cus, hipDeviceAttributeMultiprocessorCount, dev) != hipSuccess) { grid = -1; return; }
        if (hipFuncSetAttribute((const void*)fwd_kernel, hipFuncAttributeMaxDynamicSharedMemorySize, LDS_BYTES) != hipSuccess) { fprintf(stderr, "kernel_launch: hipFuncSetAttribute failed\n"); grid = -1; return; }
        if (hipOccupancyMaxActiveBlocksPerMultiprocessor(&per_cu, (const void*)fwd_kernel, NTHREADS, LDS_BYTES) != hipSuccess || per_cu < 1) { fprintf(stderr, "kernel_launch: occupancy query says %d blocks per CU\n", per_cu); (void)hipGetLastError(); grid = -1; return; }
        grid = cus;
        if (grid != 256) { fprintf(stderr, "kernel_launch: built for a 256-CU device (one workgroup per CU), found %d\n", grid); grid = -1; return; }
    }
    if (grid < 0) return;
    Args a{};
    a.x = (const float*)d_in[0]; a.meta = (const float*)d_in[1]; a.norm_mix = (const float*)d_in[2]; a.w_in = (const float*)d_in[3]; a.b_fgate = (const float*)d_in[4];
    a.b_gate = (const float*)d_in[5]; a.q_norm = (const float*)d_in[6]; a.k_norm = (const float*)d_in[7]; a.conv_w = (const float*)d_in[8]; a.w_attn_out = (const float*)d_in[9];
    a.w_conv_out = (const float*)d_in[10]; a.w_o = (const float*)d_in[11]; a.norm_mlp = (const float*)d_in[12]; a.w_up = (const float*)d_in[13]; a.w_down = (const float*)d_in[14];
    a.out = (float*)d_out; a.ws = (unsigned char*)d_ws;
    if (N_LAUNCHES == 1) {
        a.ph_lo = 0; a.ph_hi = N_PHASES;
        void* args[] = {&a};
        hipError_t e = hipLaunchCooperativeKernel((const void*)fwd_kernel, dim3(grid), dim3(NTHREADS), args, LDS_BYTES, stream);
        if (e != hipSuccess) fprintf(stderr, "kernel_launch: cooperative launch failed: %s (grid %d)\n", hipGetErrorString(e), grid);
    } else {
        for (int p = 0; p < N_PHASES; ++p) { a.ph_lo = p; a.ph_hi = p + 1; hipLaunchKernelGGL(fwd_kernel, dim3(grid), dim3(NTHREADS), LDS_BYTES, stream, a); }
    }
}
```
